# Optimizing an MI355X kernel written in HIP

```python
import jax, jax.numpy as jnp
from jax import lax
import numpy as np

D_MODEL = 1024
BATCH = 4
SEQ = 8192
DEPTH = 2

CTX_LEN = 256
GRID_W = 64
N_EVEN = (DEPTH + 1) // 2
N_ODD = DEPTH // 2
N_MOD = 6
EPS = 1e-6

MIX_WIDTH = D_MODEL
FOURIER_WIDTH = MIX_WIDTH // 2
FOURIER_GROUPS = 4
FOURIER_GROUP_DIM = FOURIER_WIDTH // FOURIER_GROUPS
GLA_HEADS = 4
GLA_VAL_WIDTH = MIX_WIDTH - FOURIER_WIDTH
GLA_DV = GLA_VAL_WIDTH // GLA_HEADS
GLA_DK = GLA_DV // 2
GLA_KEY_WIDTH = GLA_HEADS * GLA_DK
GLA_GATE_RANK = 16
GLA_GATE_TEMP = 16.0
GLA_CHUNK = 64
EVEN_SPLITS = [FOURIER_WIDTH,
               FOURIER_WIDTH + GLA_KEY_WIDTH,
               FOURIER_WIDTH + 2 * GLA_KEY_WIDTH,
               FOURIER_WIDTH + 2 * GLA_KEY_WIDTH + GLA_VAL_WIDTH,
               FOURIER_WIDTH + 2 * GLA_KEY_WIDTH + 2 * GLA_VAL_WIDTH]
EVEN_IN_WIDTH = EVEN_SPLITS[-1] + GLA_GATE_RANK

HEAD_DIM = 128
ATT_HEADS = D_MODEL // HEAD_DIM
ATT_KV_HEADS = 2
ATT_GROUP = ATT_HEADS // ATT_KV_HEADS
Q_WIDTH = ATT_HEADS * HEAD_DIM
QKV_WIDTH = (ATT_HEADS + 2 * ATT_KV_HEADS) * HEAD_DIM
Q_BLOCK = 128
ROPE_THETA = 10000.0
ROPE_AXIS_DIM = HEAD_DIM // 2

D_FF = ((8 * D_MODEL // 3 + 255) // 256) * 256
CONV_W = 3

kernel_name = 'hybrid_fourier_gla_gqa_dit_prefix'


def rms_norm(x, g):
    xf = x.astype(jnp.float32)
    y = xf * lax.rsqrt(jnp.mean(xf * xf, axis=-1, keepdims=True) + EPS)
    return (y * g.astype(jnp.float32)).astype(x.dtype)


def adaln(cv, w, b):
    m = jax.nn.silu(cv) @ w + b
    m = m.reshape(cv.shape[:-1] + (1, N_MOD, D_MODEL))
    return [m[..., k, :] for k in range(N_MOD)]


def dwconv_centred(x, w, b):
    L = x.shape[1]
    pad = CONV_W // 2
    xp = jnp.pad(x, ((0, 0), (pad, CONV_W - 1 - pad), (0, 0)))
    out = b
    for k in range(CONV_W):
        out = out + xp[:, k:k + L] * w[k]
    return out


def conv_ffn(h, w_up, w_conv, b_conv, w_down):
    u = dwconv_centred(h @ w_up, w_conv, b_conv)
    g, v = jnp.split(u, 2, axis=-1)
    return (jax.nn.silu(g) * v) @ w_down


def fourier_mix(u):
    B_, L, _ = u.shape
    ug = u.reshape(B_, L, FOURIER_GROUPS, FOURIER_GROUP_DIM).astype(jnp.float32)
    f = jnp.fft.fft2(ug, axes=(1, 3), norm='ortho').real
    return f.reshape(B_, L, FOURIER_WIDTH).astype(u.dtype)


def gla_scan(q, k, v, loga, s0):
    q, k, v = (t.astype(jnp.float32) for t in (q, k, v))
    B_, H, L, _ = q.shape
    n = L // GLA_CHUNK

    def to_chunks(t):
        return jnp.moveaxis(t.reshape(B_, H, n, GLA_CHUNK, t.shape[-1]), 2, 0)

    mask = jnp.tril(jnp.ones((GLA_CHUNK, GLA_CHUNK), bool))[:, :, None]

    def step(S, inp):
        qc, kc, vc, ac = inp
        b = jnp.cumsum(ac, axis=2)
        diff = b[:, :, :, None, :] - b[:, :, None, :, :]
        decay = jnp.exp(jnp.where(mask, diff, -jnp.inf))
        attn = jnp.einsum('bhid,bhjd,bhijd->bhij', qc, kc, decay)
        o = attn @ vc + jnp.einsum('bhid,bhde->bhie', qc * jnp.exp(b), S)
        b_last = b[:, :, -1:, :]
        S_new = (jnp.exp(b_last[:, :, 0, :, None]) * S
                 + jnp.einsum('bhjd,bhje->bhde', kc * jnp.exp(b_last - b), vc))
        return S_new, o

    s_fin, o = lax.scan(step, s0, (to_chunks(q), to_chunks(k), to_chunks(v), to_chunks(loga)))
    o = jnp.moveaxis(o, 0, 2).reshape(B_, H, L, v.shape[-1])
    return o, s_fin


def even_mix(h, s_f, s_b, w_in, w_gate, b_gate, g_gla, w_out):
    B_, L, _ = h.shape
    p = h @ w_in
    u_f, q, k, v, r, z = jnp.split(p, EVEN_SPLITS, axis=-1)

    def heads(t, d):
        return t.reshape(B_, L, GLA_HEADS, d).transpose(0, 2, 1, 3)

    q = heads(q, GLA_DK) * (GLA_DK ** -0.5)
    k = heads(k, GLA_DK)
    v = heads(v, GLA_DV)
    zf = z.astype(jnp.float32)
    loga = [heads(jax.nn.log_sigmoid(zf @ w_gate[d].astype(jnp.float32) + b_gate[d].astype(jnp.float32))
                  / GLA_GATE_TEMP, GLA_DK) for d in range(2)]

    def flip(t):
        return jnp.flip(t, axis=2)

    o_f, s_f = gla_scan(q, k, v, loga[0], s_f)
    o_b, s_b = gla_scan(flip(q), flip(k), flip(v), flip(loga[1]), s_b)
    o = o_f + flip(o_b)
    o = o * lax.rsqrt(jnp.mean(o * o, axis=-1, keepdims=True) + EPS)
    o = o.transpose(0, 2, 1, 3).reshape(B_, L, GLA_VAL_WIDTH) * g_gla.astype(jnp.float32)
    o = (o * jax.nn.silu(r.astype(jnp.float32))).astype(h.dtype)
    y = jnp.concatenate([fourier_mix(u_f), o], axis=-1) @ w_out
    return y, s_f, s_b


def axial_rope_tables(n_tokens):
    rows = n_tokens // GRID_W
    r, c = jnp.meshgrid(jnp.arange(rows), jnp.arange(GRID_W), indexing='ij')
    inv = ROPE_THETA ** (-jnp.arange(0, ROPE_AXIS_DIM, 2, dtype=jnp.float32) / ROPE_AXIS_DIM)
    ang = jnp.concatenate([r.reshape(-1, 1).astype(jnp.float32) * inv,
                           c.reshape(-1, 1).astype(jnp.float32) * inv], axis=-1)
    return jnp.cos(ang), jnp.sin(ang)


def apply_rope(t, cos, sin):
    tf = t.astype(jnp.float32)
    t1, t2 = jnp.split(tf, 2, axis=-1)
    return jnp.concatenate([t1 * cos - t2 * sin, t1 * sin + t2 * cos], axis=-1).astype(t.dtype)


def attn_q(h, w_q, g_q):
    B_, L, _ = h.shape
    q = rms_norm((h @ w_q).reshape(B_, L, ATT_HEADS, HEAD_DIM), g_q)
    return q.transpose(0, 2, 1, 3)


def attn_kv(h, w_kv, g_k):
    B_, L, _ = h.shape
    kv = (h @ w_kv).reshape(B_, L, 2, ATT_KV_HEADS, HEAD_DIM)
    k = rms_norm(kv[:, :, 0], g_k).transpose(0, 2, 1, 3)
    v = kv[:, :, 1].transpose(0, 2, 1, 3)
    return k, v


def grouped_attend(q, k, v):
    s = jnp.einsum('bkgqd,bksd->bkgqs', q, k).astype(jnp.float32) * (HEAD_DIM ** -0.5)
    p = jax.nn.softmax(s, axis=-1).astype(v.dtype)
    return jnp.einsum('bkgqs,bksd->bkgqd', p, v)


def setup_inputs(seed: int = 0) -> dict:
    key = jax.random.key(seed)
    ks = jax.random.split(key, 22)
    f32 = jnp.float32

    def nrm(k, shape, scale):
        return jax.random.normal(k, shape, f32) * scale

    def gain(k, shape):
        return 1.0 + 0.02 * jax.random.normal(k, shape, f32)

    return {
        'x': nrm(ks[0], (BATCH, SEQ, D_MODEL), 1.0),
        'c': nrm(ks[1], (BATCH, D_MODEL), 1.0),
        'ctx': nrm(ks[2], (BATCH, CTX_LEN, D_MODEL), 1.0),
        'c_ctx': nrm(ks[3], (D_MODEL,), 1.0),
        'w_mod': nrm(ks[4], (DEPTH, D_MODEL, N_MOD * D_MODEL), D_MODEL ** -0.5),
        'b_mod': nrm(ks[5], (DEPTH, N_MOD * D_MODEL), 0.02),
        'g_norm_mix': gain(ks[6], (DEPTH, D_MODEL)),
        'g_norm_ffn': gain(ks[7], (DEPTH, D_MODEL)),
        'g_norm_final': gain(ks[8], (D_MODEL,)),
        'w_even_in': nrm(ks[9], (N_EVEN, D_MODEL, EVEN_IN_WIDTH), D_MODEL ** -0.5),
        'w_gla_gate': nrm(ks[10], (N_EVEN, 2, GLA_GATE_RANK, GLA_KEY_WIDTH), GLA_GATE_RANK ** -0.5),
        'b_gla_gate': nrm(ks[11], (N_EVEN, 2, GLA_KEY_WIDTH), 0.1),
        'g_gla_out': gain(ks[12], (N_EVEN, GLA_VAL_WIDTH)),
        'w_even_out': nrm(ks[13], (N_EVEN, MIX_WIDTH, D_MODEL), MIX_WIDTH ** -0.5),
        'w_qkv': nrm(ks[14], (N_ODD, D_MODEL, QKV_WIDTH), D_MODEL ** -0.5),
        'g_q': gain(ks[15], (N_ODD, HEAD_DIM)),
        'g_k': gain(ks[16], (N_ODD, HEAD_DIM)),
        'w_att_out': nrm(ks[17], (N_ODD, Q_WIDTH, D_MODEL), Q_WIDTH ** -0.5),
        'w_ffn_up': nrm(ks[18], (DEPTH, D_MODEL, 2 * D_FF), D_MODEL ** -0.5),
        'w_ffn_conv': nrm(ks[19], (DEPTH, CONV_W, 2 * D_FF), CONV_W ** -0.5),
        'b_ffn_conv': nrm(ks[20], (DEPTH, 2 * D_FF), 0.02),
        'w_ffn_down': nrm(ks[21], (DEPTH, D_FF, D_MODEL), D_FF ** -0.5),
    }


def reference(x, c, ctx, c_ctx, w_mod, b_mod, g_norm_mix, g_norm_ffn, g_norm_final,
              w_even_in, w_gla_gate, b_gla_gate, g_gla_out, w_even_out,
              w_qkv, g_q, g_k, w_att_out,
              w_ffn_up, w_ffn_conv, b_ffn_conv, w_ffn_down):
    B_, S, _ = x.shape
    cos, sin = axial_rope_tables(S)
    h_lat, h_ctx = x, ctx
    for i in range(DEPTH):
        last = i == DEPTH - 1
        j = i // 2
        sh1, sc1, ga1, sh2, sc2, ga2 = adaln(c, w_mod[i], b_mod[i])
        csh1, csc1, cga1, csh2, csc2, cga2 = adaln(c_ctx, w_mod[i], b_mod[i])
        a_lat = rms_norm(h_lat, g_norm_mix[i]) * (1 + sc1) + sh1
        a_ctx = rms_norm(h_ctx, g_norm_mix[i]) * (1 + csc1) + csh1
        if i % 2 == 0:
            zero = jnp.zeros((B_, GLA_HEADS, GLA_DK, GLA_DV), jnp.float32)
            o_ctx, s_f, s_b = even_mix(a_ctx, zero, zero, w_even_in[j], w_gla_gate[j],
                                       b_gla_gate[j], g_gla_out[j], w_even_out[j])
            o_lat, _, _ = even_mix(a_lat, s_f, s_b, w_even_in[j], w_gla_gate[j],
                                   b_gla_gate[j], g_gla_out[j], w_even_out[j])
        else:
            w_q = w_qkv[j][:, :Q_WIDTH]
            w_kv = w_qkv[j][:, Q_WIDTH:]
            q_l = apply_rope(attn_q(a_lat, w_q, g_q[j]), cos, sin)
            k_l, v_l = attn_kv(a_lat, w_kv, g_k[j])
            k_l = apply_rope(k_l, cos, sin)
            k_c, v_c = attn_kv(a_ctx, w_kv, g_k[j])
            k_all = jnp.concatenate([k_c, k_l], axis=2)
            v_all = jnp.concatenate([v_c, v_l], axis=2)
            nb = S // Q_BLOCK
            qb = jnp.moveaxis(q_l.reshape(B_, ATT_KV_HEADS, ATT_GROUP, nb, Q_BLOCK, HEAD_DIM), 3, 0)
            ob = lax.map(lambda blk: grouped_attend(blk, k_all, v_all), qb)
            o_lat = ob.transpose(1, 0, 4, 2, 3, 5).reshape(B_, S, Q_WIDTH) @ w_att_out[j]
            if not last:
                Lc = a_ctx.shape[1]
                q_c = attn_q(a_ctx, w_q, g_q[j]).reshape(B_, ATT_KV_HEADS, ATT_GROUP, Lc, HEAD_DIM)
                o_c = grouped_attend(q_c, k_c, v_c)
                o_ctx = o_c.transpose(0, 3, 1, 2, 4).reshape(B_, Lc, Q_WIDTH) @ w_att_out[j]
        h_lat = h_lat + ga1 * o_lat
        f_lat = rms_norm(h_lat, g_norm_ffn[i]) * (1 + sc2) + sh2
        h_lat = h_lat + ga2 * conv_ffn(f_lat, w_ffn_up[i], w_ffn_conv[i], b_ffn_conv[i], w_ffn_down[i])
        if not last:
            h_ctx = h_ctx + cga1 * o_ctx
            f_ctx = rms_norm(h_ctx, g_norm_ffn[i]) * (1 + csc2) + csh2
            h_ctx = h_ctx + cga2 * conv_ffn(f_ctx, w_ffn_up[i], w_ffn_conv[i], b_ffn_conv[i], w_ffn_down[i])
    return rms_norm(h_lat, g_norm_final)
```

```cpp
#include <hip/hip_runtime.h>
#include <hip/hip_cooperative_groups.h>
#include <cstdio>
#include <cstdint>
namespace cg = cooperative_groups;

#define LAS __attribute__((address_space(3)))
typedef unsigned short bf16_t;
typedef short bf16x8 __attribute__((ext_vector_type(8)));
typedef short s16x4 __attribute__((ext_vector_type(4)));
typedef float f32x4 __attribute__((ext_vector_type(4)));
typedef float f32x2 __attribute__((ext_vector_type(2)));
typedef float f32x16 __attribute__((ext_vector_type(16)));
typedef unsigned u32x4 __attribute__((ext_vector_type(4)));
typedef unsigned u32x2 __attribute__((ext_vector_type(2)));

constexpr int DM = 1024, NB = 4, SEQ = 8192, CTXL = 256;
constexpr int NLAT = NB * SEQ, NCTX = NB * CTXL, MROWS = NLAT + NCTX;
constexpr int DFF = 2816, NUP = 5632, NIN = 2064, NINP = 2304, PW = 1792, NQKV = 1536;
constexpr int NDC = 1280;
constexpr int NCH = 132;
constexpr float EPS = 1e-6f;
constexpr int SKV = CTXL + SEQ;

constexpr size_t MiB = 1u << 20;
constexpr size_t O_MODV = 0, O_PART = 1 * MiB, O_COST = 9 * MiB, O_ROPE = 9 * MiB + 65536, O_DFTC = 9 * MiB + 262144;
constexpr size_t O_Z = 10 * MiB, O_HCTX = 13 * MiB, O_DEC = 17 * MiB;
constexpr size_t O_WIN = 20 * MiB, O_WOUT = 26 * MiB, O_WQKV = 28 * MiB, O_WATT = 31 * MiB, O_WUP = 33 * MiB, O_WDN = 55 * MiB;
constexpr size_t O_XN = 68 * MiB;
constexpr size_t O_P = 135 * MiB;
constexpr size_t O_VT = 251 * MiB, O_VTC = 315 * MiB;
constexpr size_t O_VTF = 317 * MiB, O_VTCF = 349 * MiB;
constexpr size_t O_SL = 350 * MiB;
constexpr size_t O_GH = 135 * MiB;
constexpr size_t O_QKV = 135 * MiB, O_QF = 234 * MiB, O_KALL = 298 * MiB, O_VALL = 315 * MiB, O_ATTO = 416 * MiB;
constexpr size_t O_HB = 350 * MiB;
constexpr size_t WS_NEED = 482 * MiB;
constexpr int LDS_BYTES = 147456;

__device__ __forceinline__ unsigned f2bf(float f) { unsigned u = __builtin_bit_cast(unsigned, f); return (u + 0x7fffu + ((u >> 16) & 1u)) >> 16; }
__device__ __forceinline__ unsigned pk2(float lo, float hi) { return f2bf(lo) | (f2bf(hi) << 16); }
__device__ __forceinline__ float bf2f(unsigned b) { return __builtin_bit_cast(float, b << 16); }
__device__ __forceinline__ void unpack8(const u32x4 w, float* o) { o[0] = bf2f(w.x & 0xffffu); o[1] = bf2f(w.x >> 16); o[2] = bf2f(w.y & 0xffffu); o[3] = bf2f(w.y >> 16); o[4] = bf2f(w.z & 0xffffu); o[5] = bf2f(w.z >> 16); o[6] = bf2f(w.w & 0xffffu); o[7] = bf2f(w.w >> 16); }
__device__ __forceinline__ float wave_sum(float v) {
#pragma unroll
    for (int o = 1; o < 64; o <<= 1) v += __shfl_xor(v, o);
    return v;
}
__device__ __forceinline__ float silu_f(float x) { return x * __builtin_amdgcn_rcpf(1.0f + __expf(-x)); }
#define LDS_WAIT() asm volatile("s_waitcnt lgkmcnt(0)" ::: "memory")

namespace pg8 {
constexpr int BM = 256, BK = 64, HALF = 128, HTB = HALF * BK * 2, STAGE_BYTES = 8 * HTB, NXCD = 8, WGM = 4;
__host__ __device__ __forceinline__ int lds_byte(int r, int c) { const int st = (r >> 4) * 2 + (c >> 5), rr = r & 15, cc = c & 31, ob = rr * 64 + cc * 2; return st * 1024 + (ob ^ (((ob >> 9) & 1) << 5)); }
__host__ __device__ __forceinline__ void stage_rc(int b, int& R, int& C) { const int st = b / 1024, sb = b % 1024, swz = sb ^ (((sb >> 9) & 1) << 5); R = (st >> 1) * 16 + swz / 64; C = (st & 1) * 32 + (swz % 64) / 2; }
__host__ __device__ __forceinline__ int perm32(int rho) { const int n = rho >> 4, i = rho & 15; return 8 * (i >> 2) + 4 * n + (i & 3); }
struct Unit { int pm, pn; };
struct Gemm { const bf16_t* A; const bf16_t* Bt; int K; int bsh = 30; size_t bstr = 0; };
struct StaticOrder {
    int nM, nN, nwg, G, c;
    int xn = 0, xpm0 = 0, xpn0 = 0, xcols = 1;
    __device__ void init(int nM_, int nN_, int G_, int c_) { nM = nM_; nN = nN_; nwg = nM * nN; G = G_; c = c_; }
    __device__ bool next(int i, Unit& u) const {
        const long L = (long)i * G + c; if (L >= nwg + xn) return false;
        if (L >= nwg) { const int e = (int)L - nwg; u.pm = xpm0 + e / xcols; u.pn = xpn0 + e % xcols; return true; }
        int wgid = (int)L; { const int q = nwg / NXCD, r = nwg % NXCD, xcd = wgid % NXCD, off = wgid / NXCD; wgid = (xcd < r ? xcd * (q + 1) : r * (q + 1) + (xcd - r) * q) + off; }
        const int nig = WGM * nN, gid = wgid / nig, fm = gid * WGM, gsz = (nM - fm) < WGM ? (nM - fm) : WGM;
        u.pm = fm + ((wgid % nig) % gsz); u.pn = (wgid % nig) / gsz; return true;
    }
};
__device__ __forceinline__ unsigned cvt_pk_bf16(float lo, float hi) { unsigned r; asm volatile("v_cvt_pk_bf16_f32 %0, %1, %2" : "=v"(r) : "v"(lo), "v"(hi)); return r; }

template <class Epi, bool CONV>
__device__ __forceinline__ void gemm_phase(LAS unsigned char* lds, const Gemm g, const StaticOrder& S, const Epi& E, const int tid) {
    const int wid = __builtin_amdgcn_readfirstlane(tid >> 6), lane = tid & 63, wr = wid >> 2, wc = wid & 3, fr = lane & 15, fq = lane >> 4;
    const int K = g.K, nt = K / BK;
    int voffA[2], voffB[2];
#pragma unroll
    for (int i = 0; i < 2; ++i) { int R, C; stage_rc(tid * 16 + i * 8192, R, C); const int Rb = Epi::PERM ? ((R & ~31) + perm32(R & 31)) : R;
        const int Ra = CONV ? (62 * (R >> 6) - 1 + (R & 63)) : R;
        voffA[i] = (Ra * K + C) * 2; voffB[i] = (Rb * K + C) * 2; }
    const size_t kstep = (size_t)(BK * 2);
    const size_t hsB = (size_t)HALF * K * 2, tsB = 2 * hsB;
    const size_t hsA = CONV ? (size_t)124 * K * 2 : hsB, tsA = 2 * hsA;
    const unsigned ldsw = (unsigned)wid * 1024u;
    const int aoff = lds_byte(wr * 64 + fr, fq * 8), boff = lds_byte(wc * 32 + fr, fq * 8);
#define PG8_SA(b, h) (((b) * 2 + (h)) * HTB)
#define PG8_SB(b, h) ((4 + (b) * 2 + (h)) * HTB)
#define PG8_STAGE(bufoff, gbase, voff) do { _Pragma("unroll") for (int _i = 0; _i < 2; ++_i) \
        __builtin_amdgcn_global_load_lds((const unsigned*)((const char*)(gbase) + (voff)[_i]), (LAS unsigned*)(lds + (bufoff) + ldsw + _i * 8192), 16, 0, 0); } while (0)
#define PG8_LDA(dst, b, h) do { _Pragma("unroll") for (int m = 0; m < 4; ++m) _Pragma("unroll") for (int k = 0; k < 2; ++k) dst[m][k] = *(const LAS bf16x8*)(lds + PG8_SA(b, h) + aoff + m * 2048 + k * 1024); } while (0)
#define PG8_LDB(dst, b, h) do { _Pragma("unroll") for (int n = 0; n < 2; ++n) _Pragma("unroll") for (int k = 0; k < 2; ++k) dst[n][k] = *(const LAS bf16x8*)(lds + PG8_SB(b, h) + boff + n * 2048 + k * 1024); } while (0)
#define PG8_MMA(ai, bj, At, Bt) do { __builtin_amdgcn_s_setprio(1); _Pragma("unroll") for (int m = 0; m < 4; ++m) _Pragma("unroll") for (int n = 0; n < 2; ++n) _Pragma("unroll") for (int k = 0; k < 2; ++k) \
        acc[ai][bj][m][n] = __builtin_amdgcn_mfma_f32_16x16x32_bf16(Bt[n][k], At[m][k], acc[ai][bj][m][n], 0, 0, 0); __builtin_amdgcn_s_setprio(0); } while (0)
#define PG8_WAIT_V(n) asm volatile("s_waitcnt vmcnt(" #n ")" ::: "memory")
#define PG8_WAIT_L(n) asm volatile("s_waitcnt lgkmcnt(" #n ")" ::: "memory")
#define PG8_BAR __builtin_amdgcn_s_barrier()
#define PG8_SCHED __builtin_amdgcn_sched_barrier(0)
    Unit cur, nxt; int ui = 0;
    if (!S.next(0, cur)) return;
    f32x4 acc[2][2][4][2];
#pragma unroll
    for (int a = 0; a < 2; ++a)
#pragma unroll
        for (int b = 0; b < 2; ++b)
#pragma unroll
            for (int m = 0; m < 4; ++m)
#pragma unroll
                for (int n = 0; n < 2; ++n) acc[a][b][m][n] = (f32x4){0.f, 0.f, 0.f, 0.f};
    bf16x8 At[4][2], B0[2][2], B1[2][2];
    const char* cA = (const char*)g.A + (size_t)cur.pm * tsA; const char* cB = (const char*)g.Bt + (size_t)cur.pn * tsB + (size_t)(cur.pm >> g.bsh) * g.bstr;
    PG8_STAGE(PG8_SB(0, 0), cB, voffB); PG8_STAGE(PG8_SB(0, 1), cB + hsB, voffB); PG8_STAGE(PG8_SA(0, 0), cA, voffA); PG8_STAGE(PG8_SA(0, 1), cA + hsA, voffA);
    if (wr == 1) PG8_BAR;
    PG8_WAIT_V(2); PG8_BAR;
    PG8_STAGE(PG8_SB(1, 0), cB + kstep, voffB); PG8_STAGE(PG8_SA(1, 0), cA + kstep, voffA); PG8_STAGE(PG8_SB(1, 1), cB + hsB + kstep, voffB);
    PG8_WAIT_V(6); PG8_BAR;
    for (;;) {
        const bool has_next = S.next(ui + 1, nxt);
        const char* nA = has_next ? (const char*)g.A + (size_t)nxt.pm * tsA : cA; const char* nB = has_next ? (const char*)g.Bt + (size_t)nxt.pn * tsB + (size_t)(nxt.pm >> g.bsh) * g.bstr : cB;
        for (int t = 0; t < nt; t += 2) {
            const bool last = (t == nt - 2);
            const char* a1 = cA + (size_t)(t + 1) * kstep;
            const char* a2 = last ? nA : cA + (size_t)(t + 2) * kstep; const char* b2 = last ? nB : cB + (size_t)(t + 2) * kstep;
            const char* a3 = a2 + kstep; const char* b3 = b2 + kstep;
            PG8_LDB(B0, 0, 0); PG8_LDB(B1, 0, 1); PG8_SCHED; PG8_LDA(At, 0, 0); PG8_STAGE(PG8_SA(1, 1), a1 + hsA, voffA);
            PG8_WAIT_V(8); PG8_WAIT_L(0); PG8_BAR; PG8_MMA(0, 0, At, B0); PG8_MMA(0, 1, At, B1); PG8_BAR; PG8_SCHED;
            PG8_LDA(At, 0, 1); PG8_STAGE(PG8_SB(0, 0), b2, voffB); PG8_STAGE(PG8_SB(0, 1), b2 + hsB, voffB); PG8_STAGE(PG8_SA(0, 0), a2, voffA);
            PG8_WAIT_V(8); PG8_WAIT_L(0); PG8_BAR; PG8_MMA(1, 0, At, B0); PG8_MMA(1, 1, At, B1); PG8_BAR; PG8_SCHED;
            PG8_LDB(B0, 1, 0); PG8_LDB(B1, 1, 1); PG8_SCHED; PG8_LDA(At, 1, 0); PG8_STAGE(PG8_SA(0, 1), a2 + hsA, voffA);
            PG8_WAIT_V(8); PG8_WAIT_L(0); PG8_BAR; PG8_MMA(0, 0, At, B0); PG8_MMA(0, 1, At, B1); PG8_BAR; PG8_SCHED;
            PG8_LDA(At, 1, 1); PG8_STAGE(PG8_SB(1, 0), b3, voffB); PG8_STAGE(PG8_SB(1, 1), b3 + hsB, voffB); PG8_STAGE(PG8_SA(1, 0), a3, voffA);
            PG8_WAIT_V(8); PG8_WAIT_L(0); PG8_BAR; PG8_MMA(1, 0, At, B0); PG8_MMA(1, 1, At, B1); PG8_BAR; PG8_SCHED;
        }
        if (wr == 0) PG8_BAR;
        E(acc, cur, wr, wc, fr, fq);
        if (!has_next) break;
#pragma unroll
        for (int a = 0; a < 2; ++a)
#pragma unroll
            for (int b = 0; b < 2; ++b)
#pragma unroll
                for (int m = 0; m < 4; ++m)
#pragma unroll
                    for (int n = 0; n < 2; ++n) acc[a][b][m][n] = (f32x4){0.f, 0.f, 0.f, 0.f};
        cur = nxt; cA = nA; cB = nB; ++ui;
        if (wr == 1) PG8_BAR;
    }
    PG8_WAIT_V(0);
    PG8_BAR;
#undef PG8_SA
#undef PG8_SB
#undef PG8_STAGE
#undef PG8_LDA
#undef PG8_LDB
#undef PG8_MMA
#undef PG8_WAIT_V
#undef PG8_WAIT_L
#undef PG8_BAR
#undef PG8_SCHED
}

typedef f32x4 Acc[2][2][4][2];
struct EpiIn {
    static constexpr bool PERM = true;
    bf16_t* VT; bf16_t* VTC; bf16_t* P; float* Z;
    __device__ __forceinline__ void operator()(const Acc& acc, const Unit& u, int wr, int wc, int fr_, int fq_) const {
        int fr = fr_, fq = fq_; asm volatile("" : "+v"(fr), "+v"(fq));
        const int row0 = u.pm * BM + wr * 64 + fr;
        if (u.pn < 2) {
            const int part = wc >> 1;
#pragma unroll
            for (int ai = 0; ai < 2; ++ai)
#pragma unroll
                for (int m = 0; m < 4; ++m) {
                    const int r = row0 + ai * HALF + m * 16; bf16_t* base; size_t rs; int poff, bb;
                    if (r < NLAT) { bb = r >> 13; const int t = r & 8191; base = VT + t; rs = 16384; poff = 8192; }
                    else { const int r2 = r - NLAT; bb = r2 >> 8; const int s = r2 & 255; base = VTC + s; rs = 512; poff = 256; }
#pragma unroll
                    for (int bj = 0; bj < 2; ++bj) { bf16_t* gb = base + ((size_t)(bb * 4 + 2 * u.pn + bj) * 128) * rs + part * poff;
#pragma unroll
                        for (int n = 0; n < 2; ++n)
#pragma unroll
                            for (int j = 0; j < 4; ++j) { const int mm = 32 * (wc & 1) + 8 * fq + 4 * n + j; const unsigned v = f2bf(acc[ai][bj][m][n][j]);
                                gb[(size_t)mm * rs] = (bf16_t)v; if (mm) gb[(size_t)(128 - mm) * rs] = (bf16_t)(part ? (v ^ 0x8000u) : v); } }
                }
        } else {
            const int colb = (u.pn - 2) * BM + wc * 32 + 8 * fq;
#pragma unroll
            for (int ai = 0; ai < 2; ++ai)
#pragma unroll
                for (int m = 0; m < 4; ++m) {
                    const int r = row0 + ai * HALF + m * 16; bf16_t* rowp = P + (size_t)r * PW + colb;
#pragma unroll
                    for (int bj = 0; bj < 2; ++bj) { if (u.pn == 8 && (bj == 1 || wc >= 2)) continue;
                        const f32x4 v0 = acc[ai][bj][m][0], v1 = acc[ai][bj][m][1];
                        u32x4 w; w.x = cvt_pk_bf16(v0[0], v0[1]); w.y = cvt_pk_bf16(v0[2], v0[3]); w.z = cvt_pk_bf16(v1[0], v1[1]); w.w = cvt_pk_bf16(v1[2], v1[3]);
                        *(u32x4*)(rowp + bj * HALF) = w; }
                    if (u.pn == 8 && wc == 0 && fq < 2) { float* zp = Z + (size_t)r * 16 + 8 * fq; *(f32x4*)zp = acc[ai][0][m][0]; *(f32x4*)(zp + 4) = acc[ai][0][m][1]; }
                    if (u.pn == 8 && wc == 1 && fq == 0) {
                        bf16_t* base; size_t rs; int poff, bb;
                        if (r < NLAT) { bb = r >> 13; base = VT + (r & 8191); rs = 16384; poff = 8192; } else { const int r2 = r - NLAT; bb = r2 >> 8; base = VTC + (r2 & 255); rs = 512; poff = 256; }
#pragma unroll
                        for (int j = 0; j < 4; ++j) { bf16_t* q = base + ((size_t)(bb * 4 + j) * 128 + 64) * rs; q[0] = (bf16_t)f2bf(acc[ai][0][m][0][j]); q[poff] = (bf16_t)0; } }
                }
        }
    }
};
struct EpiResB {
    static constexpr bool PERM = true;
    const float* hin32_lat; const float* hin32_ctx; const bf16_t* hin; bf16_t* out; const float* gate;
    __device__ __forceinline__ void operator()(const Acc& acc, const Unit& u, int wr, int wc, int fr, int fq) const {
        const int row0 = u.pm * BM + wr * 64 + fr, col0 = u.pn * BM + wc * 32 + 8 * fq;
        const int bi = u.pm < 128 ? (u.pm >> 5) : 4;
        f32x4 gv[2][2];
#pragma unroll
        for (int bj = 0; bj < 2; ++bj)
#pragma unroll
            for (int n = 0; n < 2; ++n) gv[bj][n] = *(const f32x4*)(gate + bi * 6144 + col0 + bj * HALF + 4 * n);
#pragma unroll
        for (int ai = 0; ai < 2; ++ai)
#pragma unroll
            for (int m = 0; m < 4; ++m) { const int r = row0 + ai * HALF + m * 16;
#pragma unroll
                for (int bj = 0; bj < 2; ++bj) { const int c = col0 + bj * HALF; f32x4 h0, h1;
                    if (hin32_lat) { const float* s = (r < NLAT ? hin32_lat + (size_t)r * DM : hin32_ctx + (size_t)(r - NLAT) * DM) + c; h0 = *(const f32x4*)s; h1 = *(const f32x4*)(s + 4); }
                    else { const u32x4 w = *(const u32x4*)(hin + (size_t)r * DM + c);
                        h0 = (f32x4){bf2f(w.x & 0xffffu), bf2f(w.x >> 16), bf2f(w.y & 0xffffu), bf2f(w.y >> 16)}; h1 = (f32x4){bf2f(w.z & 0xffffu), bf2f(w.z >> 16), bf2f(w.w & 0xffffu), bf2f(w.w >> 16)}; }
                    const f32x4 o0 = h0 + gv[bj][0] * acc[ai][bj][m][0], o1 = h1 + gv[bj][1] * acc[ai][bj][m][1];
                    u32x4 w2; w2.x = cvt_pk_bf16(o0[0], o0[1]); w2.y = cvt_pk_bf16(o0[2], o0[3]); w2.z = cvt_pk_bf16(o1[0], o1[1]); w2.w = cvt_pk_bf16(o1[2], o1[3]);
                    *(u32x4*)(out + (size_t)r * DM + c) = w2; } }
    }
};
struct EpiDft {
    static constexpr bool PERM = true;
    bf16_t* MIX; int rowbase; int Lseq;
    __device__ __forceinline__ void operator()(const Acc& acc, const Unit& u, int wr, int wc, int fr, int fq) const {
        const int k0 = u.pm * BM + wr * 64 + fr;
#pragma unroll
        for (int bj = 0; bj < 2; ++bj) { const int c = u.pn * BM + bj * HALF + wc * 32 + 8 * fq, b = c >> 9, cc = c & 511;
#pragma unroll
            for (int ai = 0; ai < 2; ++ai)
#pragma unroll
                for (int m = 0; m < 4; ++m) { const int k = k0 + ai * HALF + m * 16; const f32x4 v0 = acc[ai][bj][m][0], v1 = acc[ai][bj][m][1];
                    u32x4 w; w.x = cvt_pk_bf16(v0[0], v0[1]); w.y = cvt_pk_bf16(v0[2], v0[3]); w.z = cvt_pk_bf16(v1[0], v1[1]); w.w = cvt_pk_bf16(v1[2], v1[3]);
                    *(u32x4*)(MIX + (size_t)(rowbase + b * Lseq + k) * DM + cc) = w; } }
    }
};
struct EpiBf {
    static constexpr bool PERM = true;
    bf16_t* O; int ldc;
    __device__ __forceinline__ void operator()(const Acc& acc, const Unit& u, int wr, int wc, int fr, int fq) const {
        const int row0 = u.pm * BM + wr * 64 + fr, col0 = u.pn * BM + wc * 32 + 8 * fq;
#pragma unroll
        for (int ai = 0; ai < 2; ++ai)
#pragma unroll
            for (int m = 0; m < 4; ++m) { bf16_t* rowp = O + (size_t)(row0 + ai * HALF + m * 16) * ldc + col0;
#pragma unroll
                for (int bj = 0; bj < 2; ++bj) { const f32x4 v0 = acc[ai][bj][m][0], v1 = acc[ai][bj][m][1];
                    u32x4 w; w.x = cvt_pk_bf16(v0[0], v0[1]); w.y = cvt_pk_bf16(v0[2], v0[3]); w.z = cvt_pk_bf16(v1[0], v1[1]); w.w = cvt_pk_bf16(v1[2], v1[3]);
                    *(u32x4*)(rowp + bj * HALF) = w; } }
    }
};
template <int CTRL> __device__ __forceinline__ float dppf(float x) { return __builtin_bit_cast(float, __builtin_amdgcn_mov_dpp(__builtin_bit_cast(int, x), CTRL, 0xf, 0xf, true)); }
struct EpiUp {
    static constexpr bool PERM = true;
    bf16_t* GH; const float* wconv; const float* bconv; int nrows;
    template <bool MASK> __device__ __forceinline__ void run(const Acc& acc, const Unit& u, int wr, int wc, int fr, int fq) const {
        const int jff = u.pn * 128 + wc * 32 + 8 * fq;
        const float z0 = (fr == 0) ? 1.f : 0.f, z15 = (fr == 15) ? 1.f : 0.f;
        unsigned outp[2][4][4];
#pragma unroll
        for (int n = 0; n < 2; ++n) {
            f32x4 w0[2], w1[2], w2[2], bb[2];
#pragma unroll
            for (int bj = 0; bj < 2; ++bj) { const int col = bj * DFF + jff + 4 * n;
                w0[bj] = *(const f32x4*)(wconv + col); w1[bj] = *(const f32x4*)(wconv + NUP + col); w2[bj] = *(const f32x4*)(wconv + 2 * NUP + col); bb[bj] = *(const f32x4*)(bconv + col); }
#pragma unroll
            for (int ai = 0; ai < 2; ++ai) {
                const int rbase = u.pm * 248 + 62 * (2 * ai + wr) - 1;
                float mp[4], mn[4];
                if (MASK) {
#pragma unroll
                    for (int m = 0; m < 4; ++m) { const int r = rbase + 16 * m + fr; const int t = r < NLAT ? (r & 8191) : ((r - NLAT) & 255); const int lastt = r < NLAT ? 8191 : 255;
                        mp[m] = (t == 0) ? 0.f : 1.f; mn[m] = (t == lastt) ? 0.f : 1.f; } }
#pragma unroll
                for (int jp = 0; jp < 2; ++jp) {
                    float res[4][2];
#pragma unroll
                    for (int jj = 0; jj < 2; ++jj) { const int j = jp * 2 + jj;
                        float cv[2][4];
#pragma unroll
                        for (int bj = 0; bj < 2; ++bj) {
                            const float c0 = w0[bj][j], c1 = w1[bj][j], c2 = w2[bj][j], cb = bb[bj][j], c0z = c0 * z0, c2z = c2 * z15;
#pragma unroll
                            for (int m = 0; m < 4; ++m) { const float x = acc[ai][bj][m][n][j];
                                if (MASK) {
                                    float pv = dppf<0x111>(x), nx = dppf<0x101>(x);
                                    if (m > 0) pv += z0 * dppf<0x121>(acc[ai][bj][m > 0 ? m - 1 : 0][n][j]);
                                    if (m < 3) nx += z15 * dppf<0x12F>(acc[ai][bj][m < 3 ? m + 1 : 3][n][j]);
                                    cv[bj][m] = cb + c0 * (pv * mp[m]) + c1 * x + c2 * (nx * mn[m]);
                                } else {
                                    float s = fmaf(c1, x, cb);
                                    const float xm = acc[ai][bj][m > 0 ? m - 1 : 0][n][j], xp = acc[ai][bj][m < 3 ? m + 1 : 3][n][j];
                                    if (m == 0) asm volatile("s_nop 4\n\tv_fmac_f32_dpp %0, %1, %2 row_shr:1 row_mask:0xf bank_mask:0xf\n\tv_fmac_f32_dpp %0, %1, %3 row_shl:1 row_mask:0xf bank_mask:0xf\n\tv_fmac_f32_dpp %0, %4, %5 row_ror:15 row_mask:0xf bank_mask:0xf"
                                                             : "+v"(s) : "v"(x), "v"(c0), "v"(c2), "v"(xp), "v"(c2z));
                                    else if (m == 3) asm volatile("s_nop 4\n\tv_fmac_f32_dpp %0, %1, %2 row_shr:1 row_mask:0xf bank_mask:0xf\n\tv_fmac_f32_dpp %0, %1, %3 row_shl:1 row_mask:0xf bank_mask:0xf\n\tv_fmac_f32_dpp %0, %4, %5 row_ror:1 row_mask:0xf bank_mask:0xf"
                                                             : "+v"(s) : "v"(x), "v"(c0), "v"(c2), "v"(xm), "v"(c0z));
                                    else asm volatile("s_nop 4\n\tv_fmac_f32_dpp %0, %1, %2 row_shr:1 row_mask:0xf bank_mask:0xf\n\tv_fmac_f32_dpp %0, %1, %3 row_shl:1 row_mask:0xf bank_mask:0xf\n\tv_fmac_f32_dpp %0, %4, %5 row_ror:1 row_mask:0xf bank_mask:0xf\n\tv_fmac_f32_dpp %0, %6, %7 row_ror:15 row_mask:0xf bank_mask:0xf"
                                                             : "+v"(s) : "v"(x), "v"(c0), "v"(c2), "v"(xm), "v"(c0z), "v"(xp), "v"(c2z));
                                    cv[bj][m] = s; } }
                        }
#pragma unroll
                        for (int m = 0; m < 4; ++m) res[m][jj] = silu_f(cv[0][m]) * cv[1][m];
                    }
#pragma unroll
                    for (int m = 0; m < 4; ++m) outp[ai][m][n * 2 + jp] = cvt_pk_bf16(res[m][0], res[m][1]);
                }
            }
        }
#pragma unroll
        for (int ai = 0; ai < 2; ++ai) { const int rbase = u.pm * 248 + 62 * (2 * ai + wr) - 1;
#pragma unroll
            for (int m = 0; m < 4; ++m) { const int q = 16 * m + fr, r = rbase + q;
                if (q >= 1 && q <= 62 && r < nrows) { u32x4 w; w.x = outp[ai][m][0]; w.y = outp[ai][m][1]; w.z = outp[ai][m][2]; w.w = outp[ai][m][3]; *(u32x4*)(GH + (size_t)r * DFF + jff) = w; } } }
    }
    __device__ __forceinline__ void operator()(const Acc& acc, const Unit& u, int wr, int wc, int fr, int fq) const {
        const int lo = u.pm * 248 - 1, hi = lo + 248;
        const bool bnd = (hi >= NLAT) || ((lo & ~8191) != (hi & ~8191)) || ((lo & 8191) == 0) || ((hi & 8191) == 8191) || lo < 0 || ((lo & 8191) == 8191) || ((hi & 8191) == 0);
        if (bnd) run<true>(acc, u, wr, wc, fr, fq); else run<false>(acc, u, wr, wc, fr, fq);
    }
};
}

namespace att {
constexpr int D = 128, NW = 8, QBLK = 32, KVBLK = 64;
constexpr float SCALE = 0.088388347648318440f;
constexpr float THR = 8.f;
constexpr int LDQ = 1024, LDK = 256, LDO = 1024;
constexpr size_t SHM_V = KVBLK * D * 2, SHM_K = KVBLK * D * 2, SHM_ATTN = 2 * SHM_V + 2 * SHM_K + NW * 64 * 4;
#define KSWZ(row, colB) ((row) * 256 + ((colB) ^ (((row) & 7) << 4)))
#define SBAR() __builtin_amdgcn_sched_barrier(0)
__device__ __forceinline__ int crow(int r, int hi) { return (r & 3) + 8 * (r >> 2) + 4 * hi; }
__device__ __forceinline__ unsigned cvtpk(float lo, float hi) { unsigned r; asm volatile("v_cvt_pk_bf16_f32 %0, %1, %2" : "=v"(r) : "v"(lo), "v"(hi)); return r; }
__device__ __forceinline__ bf16x8 ld8(const bf16_t* p) { return *reinterpret_cast<const bf16x8*>(p); }
__device__ __forceinline__ void partialSM(f32x16& p0, f32x16& p1, float& m_reg, float& mn, float& alpha) {
  constexpr float C = SCALE * 1.4426950408889634f;
  float pmax = p0[0]; for (int r = 1; r < 16; ++r) pmax = fmaxf(pmax, p0[r]); for (int r = 0; r < 16; ++r) pmax = fmaxf(pmax, p1[r]);
  { auto rr = __builtin_amdgcn_permlane32_swap(__float_as_uint(pmax), __float_as_uint(pmax), false, false);
    pmax = fmaxf(__uint_as_float(rr[0]), __uint_as_float(rr[1])); }
  if (__builtin_expect(__all(pmax - m_reg <= THR / SCALE), 1)) { mn = m_reg; alpha = 1.f; }
  else { mn = fmaxf(m_reg, pmax); alpha = __builtin_amdgcn_exp2f((m_reg - mn) * C); m_reg = mn; }
  float mnC = -mn * C;
  for (int r = 0; r < 16; ++r) p0[r] = fmaf(p0[r], C, mnC); for (int r = 0; r < 16; ++r) p1[r] = fmaf(p1[r], C, mnC);
  for (int r = 0; r < 16; ++r) p0[r] = __builtin_amdgcn_exp2f(p0[r]);
}
__device__ __forceinline__ void finishSM(f32x16& p0, f32x16& p1, float alpha, float& l_reg, bf16x8& pa0, bf16x8& pa1, bf16x8& pa2, bf16x8& pa3) {
  for (int r = 0; r < 16; ++r) p1[r] = __builtin_amdgcn_exp2f(p1[r]);
  float ps = 0; for (int r = 0; r < 16; ++r) ps += p0[r]; for (int r = 0; r < 16; ++r) ps += p1[r];
  { auto rr = __builtin_amdgcn_permlane32_swap(__float_as_uint(ps), __float_as_uint(ps), false, false);
    ps = __uint_as_float(rr[0]) + __uint_as_float(rr[1]); }
  l_reg = l_reg * alpha + ps;
#define PK4(P, BASE, OUT) do { unsigned a0 = cvtpk(P[BASE + 0], P[BASE + 1]), a1 = cvtpk(P[BASE + 2], P[BASE + 3]);   \
    unsigned b0 = cvtpk(P[BASE + 4], P[BASE + 5]), b1 = cvtpk(P[BASE + 6], P[BASE + 7]);                              \
    auto r0 = __builtin_amdgcn_permlane32_swap(a0, b0, false, false); auto r1 = __builtin_amdgcn_permlane32_swap(a1, b1, false, false); \
    u32x4 w = {r0[0], r1[0], r0[1], r1[1]}; OUT = *reinterpret_cast<bf16x8*>(&w); } while (0)
  PK4(p0, 0, pa0); PK4(p0, 8, pa1); PK4(p1, 0, pa2); PK4(p1, 8, pa3);
#undef PK4
}
__device__ __forceinline__ void qkt(f32x16& p0, f32x16& p1, const bf16_t* Ks, const bf16x8* qr, int r32, int hi) {
  p0 = f32x16{}; p1 = f32x16{};
  for (int d0 = 0; d0 < 8; ++d0) { int cb = (d0 * 16 + hi * 8) * 2;
    bf16x8 b0 = *reinterpret_cast<const bf16x8*>((const char*)Ks + KSWZ(r32, cb));
    bf16x8 b1 = *reinterpret_cast<const bf16x8*>((const char*)Ks + KSWZ(32 + r32, cb));
    p0 = __builtin_amdgcn_mfma_f32_32x32x16_bf16(b0, qr[d0], p0, 0, 0, 0);
    p1 = __builtin_amdgcn_mfma_f32_32x32x16_bf16(b1, qr[d0], p1, 0, 0, 0); }
}
__device__ __forceinline__ int v_st(int k, int c) { const int kk = (k & ~0xC) | ((k & 4) << 1) | ((k & 8) >> 1); return ((kk >> 3) * 4 + (c >> 5)) * 512 + ((kk & 7) * 32 + (c & 31)) * 2; }
__device__ __forceinline__ int v_rd_base(int lane) { return ((lane & 3) << 3) | (((lane >> 2) & 3) << 6) | (((lane >> 4) & 1) << 5) | (((lane >> 5) & 1) << 8); }
constexpr int v_rd_off(int d0, int ks, int half) { return d0 * 512 + ks * 4096 + half * 2048; }
template <int OFF> __device__ __forceinline__ s16x4 tr_read(int vb) {
  s16x4 r; asm volatile("ds_read_b64_tr_b16 %0, %1 offset:%2" : "=&v"(r) : "v"(vb), "i"(OFF) : "memory"); return r;
}
template <int D0> __device__ __forceinline__ void pv_one(f32x16& od, int vb, bf16x8 pa0, bf16x8 pa1, bf16x8 pa2, bf16x8 pa3) {
  const s16x4 l0 = tr_read<v_rd_off(D0, 0, 0)>(vb), h0 = tr_read<v_rd_off(D0, 0, 1)>(vb), l1 = tr_read<v_rd_off(D0, 1, 0)>(vb), h1 = tr_read<v_rd_off(D0, 1, 1)>(vb);
  const s16x4 l2 = tr_read<v_rd_off(D0, 2, 0)>(vb), h2 = tr_read<v_rd_off(D0, 2, 1)>(vb), l3 = tr_read<v_rd_off(D0, 3, 0)>(vb), h3 = tr_read<v_rd_off(D0, 3, 1)>(vb);
  asm volatile("s_waitcnt lgkmcnt(0)" ::: "memory"); SBAR();
#define PK(L, H) (bf16x8){L[0], L[1], L[2], L[3], H[0], H[1], H[2], H[3]}
  od = __builtin_amdgcn_mfma_f32_32x32x16_bf16(pa0, PK(l0, h0), od, 0, 0, 0);
  od = __builtin_amdgcn_mfma_f32_32x32x16_bf16(pa1, PK(l1, h1), od, 0, 0, 0);
  od = __builtin_amdgcn_mfma_f32_32x32x16_bf16(pa2, PK(l2, h2), od, 0, 0, 0);
  od = __builtin_amdgcn_mfma_f32_32x32x16_bf16(pa3, PK(l3, h3), od, 0, 0, 0);
#undef PK
}
__device__ __forceinline__ void pv_d0(f32x16* o, int vb, bf16x8 pa0, bf16x8 pa1, bf16x8 pa2, bf16x8 pa3) {
  pv_one<0>(o[0], vb, pa0, pa1, pa2, pa3); pv_one<1>(o[1], vb, pa0, pa1, pa2, pa3); pv_one<2>(o[2], vb, pa0, pa1, pa2, pa3); pv_one<3>(o[3], vb, pa0, pa1, pa2, pa3);
}
__device__ __forceinline__ void attn_dense_body(const bf16_t* __restrict__ Qb, const bf16_t* __restrict__ Kh, const bf16_t* __restrict__ Vh,
                                                bf16_t* __restrict__ Ob, int seq, char* lds, const int tid) {
  constexpr int SDEPTH = 2;
  const int wid = tid >> 6, lane = tid & 63, r32 = lane & 31, hi = lane >> 5;
  bf16_t* V_lds = (bf16_t*)lds; bf16_t* K_lds = (bf16_t*)(lds + 2 * SHM_V);
  float* ws = (float*)(lds + 2 * SHM_V + 2 * SHM_K) + wid * 64; float* li_l = ws; float* al_l = ws + 32;
  float m_reg = -1e30f, l_reg = 0; f32x16 o[4] = {}; bf16x8 qr[8];
  const bf16_t* Qw = Qb + (long)(wid * QBLK + r32) * LDQ + hi * 8;
#pragma unroll
  for (int d0 = 0; d0 < 8; ++d0) qr[d0] = ld8(Qw + d0 * 16);
  const int sr = tid >> 4, sc = (tid & 15) * 8, vst0 = v_st(sr, sc), vst1 = v_st(32 + sr, sc);
  const int vb0 = (int)(uintptr_t)V_lds + v_rd_base(lane);
  struct { bf16x8 vs0, vs1, ks0, ks1; } sr_[SDEPTH];
#define SLOAD(i, k0) do { sr_[i].vs0 = ld8(&Vh[(long)((k0) + sr) * LDK + sc]); sr_[i].vs1 = ld8(&Vh[(long)((k0) + 32 + sr) * LDK + sc]); \
    sr_[i].ks0 = ld8(&Kh[(long)((k0) + sr) * LDK + sc]); sr_[i].ks1 = ld8(&Kh[(long)((k0) + 32 + sr) * LDK + sc]); } while (0)
#define SWRITE(b, i) do { *(bf16x8*)((char*)V_lds + (b) * SHM_V + vst0) = sr_[i].vs0;          \
    *(bf16x8*)((char*)V_lds + (b) * SHM_V + vst1) = sr_[i].vs1; int kc = sc * 2;               \
    *(bf16x8*)((char*)K_lds + (b) * SHM_K + KSWZ(sr, kc)) = sr_[i].ks0;                       \
    *(bf16x8*)((char*)K_lds + (b) * SHM_K + KSWZ(32 + sr, kc)) = sr_[i].ks1; } while (0)
#define SWAIT() asm volatile("s_waitcnt vmcnt(4)" ::: "memory")
#define RESC(a) do { if (__any((a) < 1.f)) { if (hi == 0) al_l[r32] = (a); asm volatile("s_waitcnt lgkmcnt(0)" ::: "memory"); \
    for (int d = 0; d < 4; ++d) for (int r = 0; r < 16; ++r) o[d][r] *= al_l[crow(r, hi)]; } } while (0)
  f32x16 pA0, pA1, pB0, pB1; float mnA, mnB, alA, alB; bf16x8 pa0, pa1, pa2, pa3; const int NT = seq / KVBLK;
  constexpr int SE = 0, SO = SDEPTH - 1;
  SLOAD(SE, 0); asm volatile("s_waitcnt vmcnt(0)" ::: "memory"); SWRITE(0, SE); __syncthreads();
  qkt(pA0, pA1, K_lds, qr, r32, hi); partialSM(pA0, pA1, m_reg, mnA, alA);
  SLOAD(SO, KVBLK); if (2 < NT) SLOAD(SE, 2 * KVBLK);
  SWAIT(); SWRITE(1, SO); __syncthreads();
  for (int j = 1; j + 1 < NT; j += 2) {
    SBAR(); qkt(pB0, pB1, (bf16_t*)((char*)K_lds + SHM_K), qr, r32, hi);
    finishSM(pA0, pA1, alA, l_reg, pa0, pa1, pa2, pa3); SBAR();
    SLOAD(SO, (j + SDEPTH) * KVBLK); SBAR();
    pv_d0(o, vb0, pa0, pa1, pa2, pa3); partialSM(pB0, pB1, m_reg, mnB, alB);
    __syncthreads(); SWAIT(); SWRITE(0, SE);
    RESC(alB); __syncthreads();
    SBAR(); qkt(pA0, pA1, K_lds, qr, r32, hi);
    finishSM(pB0, pB1, alB, l_reg, pa0, pa1, pa2, pa3); SBAR();
    if (j + 3 < NT) SLOAD(SE, (j + 1 + SDEPTH) * KVBLK); SBAR();
    pv_d0(o, vb0 + (int)SHM_V, pa0, pa1, pa2, pa3); partialSM(pA0, pA1, m_reg, mnA, alA);
    __syncthreads(); SWAIT(); SWRITE(1, SO);
    RESC(alA); __syncthreads();
  }
  SBAR(); qkt(pB0, pB1, (bf16_t*)((char*)K_lds + SHM_K), qr, r32, hi);
  finishSM(pA0, pA1, alA, l_reg, pa0, pa1, pa2, pa3); SBAR();
  pv_d0(o, vb0, pa0, pa1, pa2, pa3); partialSM(pB0, pB1, m_reg, mnB, alB);
  __syncthreads(); RESC(alB);
  finishSM(pB0, pB1, alB, l_reg, pa0, pa1, pa2, pa3); SBAR();
  pv_d0(o, vb0 + (int)SHM_V, pa0, pa1, pa2, pa3);
  if (hi == 0) li_l[r32] = l_reg; asm volatile("s_waitcnt lgkmcnt(0)" ::: "memory");
  float rli[16];
#pragma unroll
  for (int r = 0; r < 16; ++r) rli[r] = __builtin_amdgcn_rcpf(li_l[crow(r, hi)]);
  bf16_t* Ow = Ob + (long)(wid * QBLK) * LDO;
#pragma unroll
  for (int r = 0; r < 16; ++r) { int orow = crow(r, hi);
    for (int d0 = 0; d0 < 4; ++d0) Ow[(long)orow * LDO + d0 * 32 + r32] = (bf16_t)f2bf(o[d0][r] * rli[r]); }
#undef SLOAD
#undef SWRITE
#undef SWAIT
#undef RESC
}
}

struct Params {
    const float *x, *c, *ctx, *c_ctx, *w_mod, *b_mod, *g_mix, *g_ffn, *g_final, *w_in, *w_gate, *b_gate, *g_gla, *w_out, *w_qkv, *g_q, *g_k, *w_att, *w_up, *w_conv, *b_conv, *w_dn;
    float* out; unsigned char* ws;
};
struct Ctx { int tid, lane, wave, gw, NGW, G, bid; LAS unsigned char* lds; };

__device__ double cos_poly(double x) { const double x2 = x * x; double r = 1.0; for (int k = 18; k >= 1; --k) r = 1.0 - x2 / (double)((2 * k - 1) * (2 * k)) * r; return r; }
__device__ double sin_poly(double x) { const double x2 = x * x; double r = 1.0; for (int k = 18; k >= 1; --k) r = 1.0 - x2 / (double)((2 * k) * (2 * k + 1)) * r; return x * r; }
constexpr double TWO_PI = 6.283185307179586476925286766559;

__device__ __forceinline__ void tr_item(const float* W, int ldw, int colmax, int K, bf16_t* WT, int kb, int c0, int drow0, LAS float* scr, int lane) {
    const int k0 = 64 * kb, col = c0 + (lane & 31);
    float wv_[32];
#pragma unroll
    for (int i = 0; i < 32; ++i) { const int kk = 2 * i + (lane >> 5); wv_[i] = (col < colmax) ? W[(size_t)(k0 + kk) * ldw + col] : 0.f; }
#pragma unroll
    for (int i = 0; i < 32; ++i) { const int kk = 2 * i + (lane >> 5); scr[kk * 33 + (lane & 31)] = wv_[i]; }
    LDS_WAIT(); asm volatile("" ::: "memory");
    const int c = lane & 7;
#pragma unroll
    for (int j = 0; j < 4; ++j) { const int n = (lane >> 3) + 8 * j; const LAS float* s = scr + (8 * c) * 33 + n;
        u32x4 o; o.x = pk2(s[0 * 33], s[1 * 33]); o.y = pk2(s[2 * 33], s[3 * 33]); o.z = pk2(s[4 * 33], s[5 * 33]); o.w = pk2(s[6 * 33], s[7 * 33]);
        *(u32x4*)(WT + (size_t)(drow0 + n) * K + k0 + 8 * c) = o; }
    LDS_WAIT(); asm volatile("" ::: "memory");
}

__device__ __forceinline__ void phase0(const Params& p, const Ctx& F) {
    LAS float* scr = (LAS float*)(F.lds + F.wave * 16384);
    LAS float* tab = scr + 3072;
    for (int n = F.lane; n < 128; n += 64) { double xx = TWO_PI * (double)n / 128.0; if (n > 64) xx -= TWO_PI; tab[n] = (float)cos_poly(xx); }
    LDS_WAIT();
    bf16_t* WIN = (bf16_t*)(p.ws + O_WIN); bf16_t* WOUT = (bf16_t*)(p.ws + O_WOUT); bf16_t* WQKV = (bf16_t*)(p.ws + O_WQKV); bf16_t* WATT = (bf16_t*)(p.ws + O_WATT);
    bf16_t* WUP = (bf16_t*)(p.ws + O_WUP); bf16_t* WDN = (bf16_t*)(p.ws + O_WDN);
    float* PART = (float*)(p.ws + O_PART); float* COST = (float*)(p.ws + O_COST); float* ROPE = (float*)(p.ws + O_ROPE);
    constexpr int I_IN = 16 * 49, I_OUT = 16 * 32, I_QKV = 16 * 48, I_ATT = 16 * 32, I_UP = 2 * 16 * 176, I_DN = 2 * 44 * 32, I_FOLD = 4 * 128, I_ADA = 2 * 24 * 32, I_COS = 128, I_ROPE = 64, I_PADZ = 55;
    constexpr int NITEMS = I_IN + I_OUT + I_QKV + I_ATT + I_UP + I_DN + I_FOLD + I_ADA + I_COS + I_ROPE + I_PADZ;
    for (int it = F.gw; it < NITEMS; it += F.NGW) {
        int r = it;
        if (r < I_IN) { const int kb = r / 49, nb = r % 49; tr_item(p.w_in, NIN, NIN, DM, WIN, kb, 512 + 32 * nb, 512 + 32 * nb, scr, F.lane); continue; } r -= I_IN;
        if (r < I_OUT) { const int kb = r / 32, nb = r % 32; tr_item(p.w_out, DM, DM, DM, WOUT, kb, 32 * nb, 32 * nb, scr, F.lane); continue; } r -= I_OUT;
        if (r < I_QKV) { const int kb = r / 48, nb = r % 48; tr_item(p.w_qkv, NQKV, NQKV, DM, WQKV, kb, 32 * nb, 32 * nb, scr, F.lane); continue; } r -= I_QKV;
        if (r < I_ATT) { const int kb = r / 32, nb = r % 32; tr_item(p.w_att, DM, DM, DM, WATT, kb, 32 * nb, 32 * nb, scr, F.lane); continue; } r -= I_ATT;
        if (r < I_UP) { const int l = r / (16 * 176), r2 = r % (16 * 176), kb = r2 / 176, nb = r2 % 176, c0 = 32 * nb, part = c0 / DFF, jf = c0 % DFF;
            tr_item(p.w_up + (size_t)l * DM * NUP, NUP, NUP, DM, WUP + (size_t)l * NUP * DM, kb, c0, 256 * (jf >> 7) + 128 * part + (jf & 127), scr, F.lane); continue; } r -= I_UP;
        if (r < I_DN) { const int l = r / (44 * 32), r2 = r % (44 * 32), kb = r2 / 32, nb = r2 % 32;
            tr_item(p.w_dn + (size_t)l * DFF * DM, DM, DM, DFF, WDN + (size_t)l * DM * DFF, kb, 32 * nb, 32 * nb, scr, F.lane); continue; } r -= I_DN;
        if (r < I_FOLD) {
            const int g = r >> 7, k0 = (r & 127) * 8;
#pragma unroll
            for (int kk = 0; kk < 8; ++kk) { scr[F.lane * 8 + kk] = p.w_in[(size_t)(k0 + kk) * NIN + g * 128 + F.lane]; scr[(F.lane + 64) * 8 + kk] = p.w_in[(size_t)(k0 + kk) * NIN + g * 128 + 64 + F.lane]; }
            LDS_WAIT(); asm volatile("" ::: "memory");
            float ac[2][2][8];
#pragma unroll
            for (int a = 0; a < 2; ++a)
#pragma unroll
                for (int b = 0; b < 2; ++b)
#pragma unroll
                    for (int kk = 0; kk < 8; ++kk) ac[a][b][kk] = 0.f;
            for (int c = 0; c < 128; ++c) {
                const f32x4 wa = *(const LAS f32x4*)(scr + c * 8), wb = *(const LAS f32x4*)(scr + c * 8 + 4);
                const float w[8] = {wa[0], wa[1], wa[2], wa[3], wb[0], wb[1], wb[2], wb[3]};
#pragma unroll
                for (int mi = 0; mi < 2; ++mi) { const int m = F.lane + 64 * mi, i0 = (c * m) & 127; const float cs = tab[i0], sn = tab[(i0 - 32) & 127];
#pragma unroll
                    for (int kk = 0; kk < 8; ++kk) { ac[0][mi][kk] += w[kk] * cs; ac[1][mi][kk] -= w[kk] * sn; } }
            }
            const float sc = 0.08838834764831845f;
#pragma unroll
            for (int part = 0; part < 2; ++part)
#pragma unroll
                for (int mi = 0; mi < 2; ++mi) { const float* a = ac[part][mi]; u32x4 o; o.x = pk2(a[0] * sc, a[1] * sc); o.y = pk2(a[2] * sc, a[3] * sc); o.z = pk2(a[4] * sc, a[5] * sc); o.w = pk2(a[6] * sc, a[7] * sc);
                    if (mi == 0) *(u32x4*)(WIN + (size_t)(g * 128 + part * 64 + F.lane) * DM + k0) = o;
                    else if (part == 0 && F.lane == 0) *(u32x4*)(WIN + (size_t)(2080 + g) * DM + k0) = o; }
            LDS_WAIT(); asm volatile("" ::: "memory");
            continue; } r -= I_FOLD;
        if (r < I_ADA) {
            const int l = r / (24 * 32), r2 = r % (24 * 32), cb = r2 / 32, kc = r2 % 32, col = cb * 256 + F.lane * 4;
            f32x4 a[5];
#pragma unroll
            for (int v = 0; v < 5; ++v) a[v] = (f32x4){0.f, 0.f, 0.f, 0.f};
#pragma unroll
            for (int kk = 0; kk < 32; ++kk) { const int k = kc * 32 + kk; const f32x4 w = *(const f32x4*)(p.w_mod + ((size_t)l * DM + k) * 6144 + col);
#pragma unroll
                for (int v = 0; v < 5; ++v) { const float cvv = v < 4 ? p.c[v * DM + k] : p.c_ctx[k]; a[v] += silu_f(cvv) * w; } }
#pragma unroll
            for (int v = 0; v < 5; ++v) *(f32x4*)(PART + ((size_t)(l * 32 + kc) * 5 + v) * 6144 + col) = a[v];
            continue; } r -= I_ADA;
        if (r < I_COS) { const int n = r * 64 + F.lane; double xx = TWO_PI * (double)n / 8192.0; if (n > 4096) xx -= TWO_PI; COST[n] = (float)cos_poly(xx); continue; } r -= I_COS;
        if (r < I_ROPE) { const int e = r * 64 + F.lane, pos = e >> 5, i = e & 31; double inv = 1.0; for (int q = 0; q < i; ++q) inv *= 0.74989420933245582730;
            const float ang = (float)pos * (float)inv; const double a = (double)ang; const double kk = __builtin_rint(a / TWO_PI); const double rr = a - kk * TWO_PI;
            ROPE[2 * e] = (float)cos_poly(rr); ROPE[2 * e + 1] = (float)sin_poly(rr); continue; } r -= I_ROPE;
        {
            u32x4 z = {0u, 0u, 0u, 0u}; u32x4* dst = (u32x4*)(WIN + (size_t)2084 * DM) + (size_t)r * 512;
#pragma unroll
            for (int q = 0; q < 8; ++q) dst[q * 64 + F.lane] = z; }
    }
}

#define CSWZ(i) ((i) + ((i) >> 5))
__device__ __forceinline__ void dft_gen(bf16_t* dst, int L, int lsh, const LAS float* cosT, long gtid, long nth) {
    const int H = L / 2, L8 = L / 8; const float sc = 1.0f / sqrtf((float)L);
    for (long it = gtid; it < (long)L * L8; it += nth) { const int k = (int)(it / L8), j0 = (int)(it % L8) * 8; float v[8];
#pragma unroll
        for (int e = 0; e < 8; ++e) { const int j = j0 + e; float val;
            if (j < H) val = cosT[CSWZ(((k * j) << lsh) & 8191)];
            else { const int t = j - H; val = (t == 0) ? ((k & 1) ? -1.f : 1.f) : cosT[CSWZ((((k * t) << lsh) - 2048) & 8191)]; }
            v[e] = val * sc; }
        u32x4 o; o.x = pk2(v[0], v[1]); o.y = pk2(v[2], v[3]); o.z = pk2(v[4], v[5]); o.w = pk2(v[6], v[7]);
        *(u32x4*)(dst + (size_t)k * L + j0) = o; }
}
__device__ __forceinline__ void dft_gen_quarter(bf16_t* dst, const LAS float* cosT, long gtid, long nth) {
    const float sc = 1.0f / sqrtf(8192.0f);
    for (long it = gtid; it < (long)8192 * 256; it += nth) { const int r = (int)(it >> 8), t0 = (int)(it & 255) * 8, blk = r >> 11, kp = r & 2047, k = 2 * kp + (blk & 1); const bool sn = blk >= 2; float v[8];
#pragma unroll
        for (int e2 = 0; e2 < 8; ++e2) { const int t = t0 + e2; float val;
            if (!sn) val = cosT[CSWZ((k * t) & 8191)];
            else val = (t == 0) ? ((kp & 1) ? -1.f : 1.f) : cosT[CSWZ(((k * t) - 2048) & 8191)];
            v[e2] = val * sc; }
        u32x4 o; o.x = pk2(v[0], v[1]); o.y = pk2(v[2], v[3]); o.z = pk2(v[4], v[5]); o.w = pk2(v[6], v[7]);
        *(u32x4*)(dst + (size_t)r * 2048 + t0) = o; }
}
__device__ __forceinline__ void phase0b(const Params& p, const Ctx& F) {
    const long gtid = (long)F.bid * 512 + F.tid, nth = (long)F.G * 512;
    const float* PART = (const float*)(p.ws + O_PART); float* MODV = (float*)(p.ws + O_MODV); const float* COST = (const float*)(p.ws + O_COST);
    for (long i = gtid; i < 2 * 5 * 6144; i += nth) { const int l = (int)(i / (5 * 6144)), v = (int)(i / 6144) % 5, n = (int)(i % 6144); float s = p.b_mod[l * 6144 + n];
#pragma unroll 16
        for (int kc = 0; kc < 32; ++kc) s += PART[((size_t)(l * 32 + kc) * 5 + v) * 6144 + n];
        MODV[i] = s; }
    LAS float* ct = (LAS float*)F.lds;
    for (int i = F.tid; i < 8192; i += 512) ct[CSWZ(i)] = COST[i];
    __syncthreads();
    dft_gen_quarter((bf16_t*)p.out, ct, gtid, nth);
    dft_gen((bf16_t*)(p.ws + O_DFTC), CTXL, 5, ct, gtid, nth);
    __syncthreads();
}

__device__ __forceinline__ void normmod(const Ctx& F, const float* hlat, const float* hctx, const float* g, const float* modl, int ishift, int iscale, bf16_t* XN, int nrows) {
    for (int row0 = F.gw; row0 < nrows; row0 += 2 * F.NGW) {
        f32x4 v[2][4];
#pragma unroll
        for (int q = 0; q < 2; ++q) { const int row = row0 + q * F.NGW; if (row < nrows) { const float* src = row < NLAT ? hlat + (size_t)row * DM : hctx + (size_t)(row - NLAT) * DM;
#pragma unroll
            for (int j = 0; j < 4; ++j) v[q][j] = ((const f32x4*)src)[F.lane + 64 * j]; } }
#pragma unroll
        for (int q = 0; q < 2; ++q) { const int row = row0 + q * F.NGW; if (row < nrows) { const int bi = row < NLAT ? (row >> 13) : 4; const float* mv = modl + bi * 6144; float ss = 0.f;
#pragma unroll
            for (int j = 0; j < 4; ++j) ss += (v[q][j][0] * v[q][j][0] + v[q][j][1] * v[q][j][1]) + (v[q][j][2] * v[q][j][2] + v[q][j][3] * v[q][j][3]);
            const float rs = 1.0f / sqrtf(wave_sum(ss) * (1.0f / DM) + EPS);
#pragma unroll
            for (int j = 0; j < 4; ++j) { const int col = 4 * (F.lane + 64 * j); const f32x4 gg = *(const f32x4*)(g + col), sc = *(const f32x4*)(mv + iscale * DM + col), sh = *(const f32x4*)(mv + ishift * DM + col);
                const f32x4 y = v[q][j] * rs * gg * (sc + 1.0f) + sh; u32x2 o; o.x = pk2(y[0], y[1]); o.y = pk2(y[2], y[3]); *(u32x2*)(XN + (size_t)row * DM + col) = o; } } }
    }
}
__device__ __forceinline__ void normmod_b(const Ctx& F, const bf16_t* HB, const float* g, const float* modl, int ishift, int iscale, bf16_t* XN, int nrows) {
    for (int row0 = F.gw; row0 < nrows; row0 += 4 * F.NGW) {
        u32x4 w[4][2];
#pragma unroll
        for (int q = 0; q < 4; ++q) { const int row = row0 + q * F.NGW; if (row < nrows) {
#pragma unroll
            for (int j = 0; j < 2; ++j) w[q][j] = *(const u32x4*)(HB + (size_t)row * DM + 512 * j + 8 * F.lane); } }
#pragma unroll
        for (int q = 0; q < 4; ++q) { const int row = row0 + q * F.NGW; if (row < nrows) {
            const int bi = row < NLAT ? (row >> 13) : 4; const float* mv = modl + bi * 6144; float v[2][8]; float ss = 0.f;
#pragma unroll
            for (int j = 0; j < 2; ++j) { unpack8(w[q][j], v[j]);
#pragma unroll
                for (int e2 = 0; e2 < 8; ++e2) ss += v[j][e2] * v[j][e2]; }
            const float rs = 1.0f / sqrtf(wave_sum(ss) * (1.0f / DM) + EPS);
#pragma unroll
            for (int j = 0; j < 2; ++j) { const int col = 512 * j + 8 * F.lane; float y[8];
#pragma unroll
                for (int q2 = 0; q2 < 2; ++q2) { const f32x4 gg = *(const f32x4*)(g + col + 4 * q2), sc = *(const f32x4*)(mv + iscale * DM + col + 4 * q2), sh = *(const f32x4*)(mv + ishift * DM + col + 4 * q2);
#pragma unroll
                    for (int e2 = 0; e2 < 4; ++e2) y[4 * q2 + e2] = v[j][4 * q2 + e2] * rs * gg[e2] * (sc[e2] + 1.0f) + sh[e2]; }
                u32x4 o; o.x = pk2(y[0], y[1]); o.y = pk2(y[2], y[3]); o.z = pk2(y[4], y[5]); o.w = pk2(y[6], y[7]); *(u32x4*)(XN + (size_t)row * DM + col) = o; } } }
    }
}

__device__ __forceinline__ void fold_pass(const bf16_t* VT, bf16_t* VTF, int L, size_t HS, int RS, long gtid, long nth) {
    const int H = L / 2, L8 = L / 8;
    for (long it = gtid; it < (long)2048 * L8; it += nth) { const int n = (int)(it / L8), j0 = (int)(it % L8) * 8; const bf16_t* row = VT + (size_t)n * 2 * L; float v[8];
        const bool sp = j0 >= H; const int t0 = sp ? j0 - H : j0; const bf16_t* src = row + (sp ? L : 0);
        const u32x4 d = *(const u32x4*)(src + t0); const unsigned dw[4] = {d.x, d.y, d.z, d.w};
#pragma unroll
        for (int e = 0; e < 8; ++e) { const int t = t0 + e; const float a = bf2f((dw[e >> 1] >> ((e & 1) * 16)) & 0xffffu);
            if (t == 0) v[e] = sp ? bf2f(row[H]) : a;
            else { const float m = bf2f(src[L - t]); v[e] = sp ? (a - m) : (a + m); } }
        u32x4 o; o.x = pk2(v[0], v[1]); o.y = pk2(v[2], v[3]); o.z = pk2(v[4], v[5]); o.w = pk2(v[6], v[7]);
        *(u32x4*)(VTF + (sp ? HS : (size_t)0) + (size_t)n * RS + t0) = o; }
}

__device__ __forceinline__ void fold4_pass(const bf16_t* VT, bf16_t* VTF, long gtid, long nth) {
    constexpr int L = 8192, H = 4096, M = 2048; constexpr size_t BS = (size_t)NDC * 2048;
    for (long it = gtid; it < (long)1040 * 256; it += nth) { const int n = (int)(it >> 8), t0 = (int)(it & 255) * 8; const int vrow = n < 1024 ? (n >> 6) * 128 + (n & 63) : (n - 1024) * 128 + 64;
        const bf16_t* x = VT + (size_t)vrow * 2 * L; const bf16_t* y = x + L;
        float xa[8], xb[8], xc[8], xd[8], ya[8], yb[8], yc[8], yd[8];
        unpack8(*(const u32x4*)(x + t0), xa); unpack8(*(const u32x4*)(x + H + t0), xd); unpack8(*(const u32x4*)(y + t0), ya); unpack8(*(const u32x4*)(y + H + t0), yd);
        { float m1[8], m2[8], m3[8], m4[8];
          unpack8(*(const u32x4*)(x + L - t0 - 8), m1); unpack8(*(const u32x4*)(x + H - t0 - 8), m2); unpack8(*(const u32x4*)(y + L - t0 - 8), m3); unpack8(*(const u32x4*)(y + H - t0 - 8), m4);
#pragma unroll
          for (int e2 = 1; e2 < 8; ++e2) { xb[e2] = m1[8 - e2]; xc[e2] = m2[8 - e2]; yb[e2] = m3[8 - e2]; yc[e2] = m4[8 - e2]; }
          xb[0] = t0 > 0 ? bf2f(x[L - t0]) : 0.f; xc[0] = bf2f(x[H - t0]); yb[0] = t0 > 0 ? bf2f(y[L - t0]) : 0.f; yc[0] = bf2f(y[H - t0]); }
        float o0[8], o1[8], o2[8], o3[8];
#pragma unroll
        for (int e2 = 0; e2 < 8; ++e2) { const float xs = xa[e2] + xb[e2], xt = xc[e2] + xd[e2], ys = ya[e2] - yb[e2], yt = yc[e2] - yd[e2];
            o0[e2] = xs + xt; o1[e2] = xs - xt; o2[e2] = ys - yt; o3[e2] = ys + yt; }
        if (t0 == 0) { o0[0] = xa[0] + xc[0]; o1[0] = xa[0] - xc[0]; o2[0] = bf2f(x[M]) + bf2f(x[L - M]); o3[0] = bf2f(y[M]) - bf2f(y[L - M]); }
        const size_t off = (size_t)n * 2048 + t0; u32x4 w;
        w.x = pk2(o0[0], o0[1]); w.y = pk2(o0[2], o0[3]); w.z = pk2(o0[4], o0[5]); w.w = pk2(o0[6], o0[7]); *(u32x4*)(VTF + off) = w;
        w.x = pk2(o1[0], o1[1]); w.y = pk2(o1[2], o1[3]); w.z = pk2(o1[4], o1[5]); w.w = pk2(o1[6], o1[7]); *(u32x4*)(VTF + BS + off) = w;
        w.x = pk2(o2[0], o2[1]); w.y = pk2(o2[2], o2[3]); w.z = pk2(o2[4], o2[5]); w.w = pk2(o2[6], o2[7]); *(u32x4*)(VTF + 2 * BS + off) = w;
        w.x = pk2(o3[0], o3[1]); w.y = pk2(o3[2], o3[3]); w.z = pk2(o3[4], o3[5]); w.w = pk2(o3[6], o3[7]); *(u32x4*)(VTF + 3 * BS + off) = w; }
}

struct GlaUnit { int b, h, row0, pf, pb; };
__device__ __forceinline__ GlaUnit gla_unit(int u) { GlaUnit g; const int bh = u & 15, cc = u >> 4; g.b = bh >> 2; g.h = bh & 3;
    if (cc < 4) { g.row0 = NLAT + g.b * CTXL + 64 * cc; g.pf = cc; g.pb = 3 - cc; } else { g.row0 = g.b * SEQ + 64 * (cc - 4); g.pf = cc; g.pb = 135 - cc; } return g; }
__device__ __forceinline__ size_t sl_off(int dir, int b, int h, int p) { return ((size_t)((dir * 4 + b) * 4 + h) * NCH + p) * 8192; }
__device__ __forceinline__ size_t dec_off(int dir, int b, int h, int p) { return ((size_t)((dir * 4 + b) * 4 + h) * NCH + p) * 64; }
#define LBAR() do { asm volatile("s_waitcnt lgkmcnt(0)" ::: "memory"); __builtin_amdgcn_s_barrier(); asm volatile("" ::: "memory"); } while (0)
__device__ __forceinline__ void gla_cum(const Ctx& F, int dir, LAS float* Bc, const LAS float* Zs, const LAS float* Wg, LAS float* Seg) {
    const int d = F.tid & 63, seg = F.tid >> 6; const LAS float* wgd = Wg + dir * 17 * 64 + d; float t[8];
    float wr[16];
#pragma unroll
    for (int r = 0; r < 16; ++r) wr[r] = wgd[r * 64];
    const float bias = wgd[16 * 64];
#pragma unroll
    for (int it = 0; it < 8; ++it) { const int i = 8 * seg + it; float s = bias;
#pragma unroll
        for (int q = 0; q < 4; ++q) { const f32x4 z = *(const LAS f32x4*)(Zs + i * 16 + 4 * q); s += z[0] * wr[4 * q] + z[1] * wr[4 * q + 1] + z[2] * wr[4 * q + 2] + z[3] * wr[4 * q + 3]; }
        t[it] = (fminf(s, 0.f) - __logf(1.0f + __expf(-fabsf(s)))) * (1.0f / 16.0f); }
    if (dir == 0) {
#pragma unroll
        for (int it = 1; it < 8; ++it) t[it] += t[it - 1];
        Seg[seg * 64 + d] = t[7];
    } else {
#pragma unroll
        for (int it = 6; it >= 0; --it) t[it] += t[it + 1];
        Seg[seg * 64 + d] = t[0];
    }
    LBAR();
    float off = 0.f;
#pragma unroll
    for (int s2 = 0; s2 < 8; ++s2) { const float v = Seg[s2 * 64 + d]; const bool use = dir == 0 ? (s2 < seg) : (s2 > seg); off += use ? v : 0.f; }
#pragma unroll
    for (int it = 0; it < 8; ++it) Bc[(8 * seg + it) * 64 + d] = t[it] + off;
    LBAR();
}
__device__ __forceinline__ void gla_cum2(const Ctx& F, LAS float* Bc0, LAS float* Bc1, const LAS float* Zs, const LAS float* Wg, LAS float* Seg) {
    const int d = F.tid & 63, seg = F.tid >> 6; const LAS float* w0p = Wg + d; const LAS float* w1p = Wg + 17 * 64 + d; float t0[8], t1[8], w0[16], w1[16];
#pragma unroll
    for (int r = 0; r < 16; ++r) { w0[r] = w0p[r * 64]; w1[r] = w1p[r * 64]; }
    const float b0 = w0p[16 * 64], b1 = w1p[16 * 64];
#pragma unroll
    for (int it = 0; it < 8; ++it) { const int i = 8 * seg + it; float s0 = b0, s1 = b1;
#pragma unroll
        for (int q = 0; q < 4; ++q) { const f32x4 z = *(const LAS f32x4*)(Zs + i * 16 + 4 * q);
            s0 += z[0] * w0[4 * q] + z[1] * w0[4 * q + 1] + z[2] * w0[4 * q + 2] + z[3] * w0[4 * q + 3];
            s1 += z[0] * w1[4 * q] + z[1] * w1[4 * q + 1] + z[2] * w1[4 * q + 2] + z[3] * w1[4 * q + 3]; }
        t0[it] = (fminf(s0, 0.f) - __logf(1.0f + __expf(-fabsf(s0)))) * (1.0f / 16.0f);
        t1[it] = (fminf(s1, 0.f) - __logf(1.0f + __expf(-fabsf(s1)))) * (1.0f / 16.0f); }
#pragma unroll
    for (int it = 1; it < 8; ++it) t0[it] += t0[it - 1];
#pragma unroll
    for (int it = 6; it >= 0; --it) t1[it] += t1[it + 1];
    Seg[seg * 64 + d] = t0[7]; Seg[512 + seg * 64 + d] = t1[0];
    LBAR();
    float off0 = 0.f, off1 = 0.f;
#pragma unroll
    for (int s2 = 0; s2 < 8; ++s2) { const float v0 = Seg[s2 * 64 + d], v1 = Seg[512 + s2 * 64 + d]; off0 += (s2 < seg) ? v0 : 0.f; off1 += (s2 > seg) ? v1 : 0.f; }
#pragma unroll
    for (int it = 0; it < 8; ++it) { Bc0[(8 * seg + it) * 64 + d] = t0[it] + off0; Bc1[(8 * seg + it) * 64 + d] = t1[it] + off1; }
    LBAR();
}
#define MFMA32F(a, b, c) __builtin_amdgcn_mfma_f32_32x32x2f32((a), (b), (c), 0, 0, 0)
#define MFMA_K64(acc, AEXPR, BEXPR) do { _Pragma("unroll 1") for (int s_ = 0; s_ < 4; ++s_) { float av_[8], bv_[8]; \
    _Pragma("unroll") for (int j_ = 0; j_ < 8; ++j_) { const int k_ = 16 * s_ + 8 * lh + j_; av_[j_] = AEXPR; bv_[j_] = BEXPR; } \
    u32x4 aw_, bw_; aw_.x = pg8::cvt_pk_bf16(av_[0], av_[1]); aw_.y = pg8::cvt_pk_bf16(av_[2], av_[3]); aw_.z = pg8::cvt_pk_bf16(av_[4], av_[5]); aw_.w = pg8::cvt_pk_bf16(av_[6], av_[7]); \
    bw_.x = pg8::cvt_pk_bf16(bv_[0], bv_[1]); bw_.y = pg8::cvt_pk_bf16(bv_[2], bv_[3]); bw_.z = pg8::cvt_pk_bf16(bv_[4], bv_[5]); bw_.w = pg8::cvt_pk_bf16(bv_[6], bv_[7]); \
    acc = __builtin_amdgcn_mfma_f32_32x32x16_bf16(__builtin_bit_cast(bf16x8, aw_), __builtin_bit_cast(bf16x8, bw_), acc, 0, 0, 0); } } while (0)
#define MFMA_K64X2(accA, accB, A0EXPR, A1EXPR, BEXPR) do { _Pragma("unroll 1") for (int s_ = 0; s_ < 4; ++s_) { float a0_[8], a1_[8], bv_[8]; \
    _Pragma("unroll") for (int j_ = 0; j_ < 8; ++j_) { const int k_ = 16 * s_ + 8 * lh + j_; a0_[j_] = A0EXPR; a1_[j_] = A1EXPR; bv_[j_] = BEXPR; } \
    u32x4 aw_, cw_, bw_; aw_.x = pg8::cvt_pk_bf16(a0_[0], a0_[1]); aw_.y = pg8::cvt_pk_bf16(a0_[2], a0_[3]); aw_.z = pg8::cvt_pk_bf16(a0_[4], a0_[5]); aw_.w = pg8::cvt_pk_bf16(a0_[6], a0_[7]); \
    cw_.x = pg8::cvt_pk_bf16(a1_[0], a1_[1]); cw_.y = pg8::cvt_pk_bf16(a1_[2], a1_[3]); cw_.z = pg8::cvt_pk_bf16(a1_[4], a1_[5]); cw_.w = pg8::cvt_pk_bf16(a1_[6], a1_[7]); \
    bw_.x = pg8::cvt_pk_bf16(bv_[0], bv_[1]); bw_.y = pg8::cvt_pk_bf16(bv_[2], bv_[3]); bw_.z = pg8::cvt_pk_bf16(bv_[4], bv_[5]); bw_.w = pg8::cvt_pk_bf16(bv_[6], bv_[7]); \
    accA = __builtin_amdgcn_mfma_f32_32x32x16_bf16(__builtin_bit_cast(bf16x8, aw_), __builtin_bit_cast(bf16x8, bw_), accA, 0, 0, 0); \
    accB = __builtin_amdgcn_mfma_f32_32x32x16_bf16(__builtin_bit_cast(bf16x8, cw_), __builtin_bit_cast(bf16x8, bw_), accB, 0, 0, 0); } } while (0)
#define GLA_LOADV(g_) do { _Pragma("unroll") for (int q_ = 0; q_ < 2; ++q_) { const int e_ = F.tid + 512 * q_, j_ = e_ >> 4, c8_ = (e_ & 15) * 8; nv[q_] = *(const u32x4*)(P + (size_t)((g_).row0 + j_) * PW + 512 + (g_).h * 128 + c8_); } \
    nk = *(const u32x4*)(P + (size_t)((g_).row0 + sj) * PW + 256 + (g_).h * 64 + sd8); if (F.tid < 256) nz = *(const f32x4*)(Z + (size_t)(g_).row0 * 16 + 4 * F.tid); } while (0)
#define GLA_PUTV() do { _Pragma("unroll") for (int q_ = 0; q_ < 2; ++q_) { const int e_ = F.tid + 512 * q_, j_ = e_ >> 4, c8_ = (e_ & 15) * 8; float v_[8]; unpack8(nv[q_], v_); \
    *(LAS f32x4*)(Vs + j_ * 128 + c8_) = (f32x4){v_[0], v_[1], v_[2], v_[3]}; *(LAS f32x4*)(Vs + j_ * 128 + c8_ + 4) = (f32x4){v_[4], v_[5], v_[6], v_[7]}; } \
    if (F.tid < 256) *(LAS f32x4*)(Zs + 4 * F.tid) = nz; } while (0)
#define GLA_LOADWG(h_) do { LBAR(); for (int e_ = F.tid; e_ < 2 * 17 * 64; e_ += 512) { const int dr_ = e_ / (17 * 64), r_ = (e_ / 64) % 17, d_ = e_ & 63; \
    Wg[e_] = r_ < 16 ? p.w_gate[(size_t)dr_ * 16 * 256 + r_ * 256 + (h_) * 64 + d_] : p.b_gate[dr_ * 256 + (h_) * 64 + d_]; } } while (0)
__device__ __forceinline__ void gla_passA(const Params& p, const Ctx& F) {
    const bf16_t* P = (const bf16_t*)(p.ws + O_P); const float* Z = (const float*)(p.ws + O_Z); bf16_t* SL = (bf16_t*)(p.ws + O_SL); float* DEC = (float*)(p.ws + O_DEC);
    LAS float* Bc0 = (LAS float*)F.lds; LAS float* Bc1 = Bc0 + 4096; LAS float* Kh0 = Bc1 + 4096; LAS float* Kh1 = Kh0 + 4096; LAS float* Vs = Kh1 + 4096;
    LAS float* Zs = Vs + 8192; LAS float* Wg = Zs + 1024; LAS float* Seg = Wg + 2 * 17 * 64;
    const int l31 = F.lane & 31, lh = F.lane >> 5, dt = F.wave >> 2, et = F.wave & 3;
    const int sj = F.tid >> 3, sd8 = (F.tid & 7) * 8;
    constexpr int NU = NCH * 16;
    u32x4 nv[2], nk; f32x4 nz = {0.f, 0.f, 0.f, 0.f}; int hcur = -1;
    int u = F.bid; if (u < NU) { const GlaUnit g0 = gla_unit(u); GLA_LOADV(g0); }
    for (; u < NU; u += F.G) { const GlaUnit g = gla_unit(u);
        if (g.h != hcur) { GLA_LOADWG(g.h); hcur = g.h; }
        GLA_PUTV(); float kr[8]; unpack8(nk, kr);
        if (u + F.G < NU) { const GlaUnit gn = gla_unit(u + F.G); GLA_LOADV(gn); }
        LBAR();
        gla_cum2(F, Bc0, Bc1, Zs, Wg, Seg);
#pragma unroll
        for (int q = 0; q < 8; ++q) { Kh0[sj * 64 + sd8 + q] = kr[q] * __expf(Bc0[63 * 64 + sd8 + q] - Bc0[sj * 64 + sd8 + q]);
                                      Kh1[sj * 64 + sd8 + q] = kr[q] * __expf(Bc1[sd8 + q] - Bc1[sj * 64 + sd8 + q]); }
        if (F.tid < 64) DEC[dec_off(0, g.b, g.h, g.pf) + F.tid] = __expf(Bc0[63 * 64 + F.tid]);
        else if (F.tid < 128) DEC[dec_off(1, g.b, g.h, g.pb) + F.tid - 64] = __expf(Bc1[F.tid - 64]);
        LBAR();
        f32x16 acc0 = {}, acc1 = {};
        MFMA_K64X2(acc0, acc1, Kh0[k_ * 64 + 32 * dt + l31], Kh1[k_ * 64 + 32 * dt + l31], Vs[k_ * 128 + 32 * et + l31]);
        bf16_t* dst0 = SL + sl_off(0, g.b, g.h, g.pf); bf16_t* dst1 = SL + sl_off(1, g.b, g.h, g.pb);
#pragma unroll
        for (int r = 0; r < 16; ++r) { const int d = 32 * dt + (r & 3) + 8 * (r >> 2) + 4 * lh; dst0[d * 128 + 32 * et + l31] = (bf16_t)f2bf(acc0[r]); dst1[d * 128 + 32 * et + l31] = (bf16_t)f2bf(acc1[r]); }
        LBAR();
    }
}
__device__ __forceinline__ void gla_passB(const Params& p, const Ctx& F) {
    bf16_t* SL = (bf16_t*)(p.ws + O_SL); const float* DEC = (const float*)(p.ws + O_DEC);
    for (int pi = F.bid * 512 + F.tid; pi < 32 * 4096; pi += F.G * 512) {
        const int chain = pi >> 12, idx = (pi & 4095) * 2, d = idx >> 7;
        unsigned* sl = (unsigned*)(SL + (size_t)chain * NCH * 8192 + idx); const float* dc = DEC + (size_t)chain * NCH * 64 + d; float s0 = 0.f, s1 = 0.f;
        for (int p0 = 0; p0 < NCH; p0 += 12) { unsigned t[12]; float dd[12];
#pragma unroll
            for (int q = 0; q < 12; ++q) { t[q] = sl[(size_t)(p0 + q) * 4096]; dd[q] = dc[(p0 + q) * 64]; }
#pragma unroll
            for (int q = 0; q < 12; ++q) { sl[(size_t)(p0 + q) * 4096] = pk2(s0, s1); s0 = dd[q] * s0 + bf2f(t[q] & 0xffffu); s1 = dd[q] * s1 + bf2f(t[q] >> 16); } }
    }
}
__device__ __forceinline__ void gla_passC(const Params& p, const Ctx& F) {
    const bf16_t* P = (const bf16_t*)(p.ws + O_P); const float* Z = (const float*)(p.ws + O_Z); const bf16_t* SL = (const bf16_t*)(p.ws + O_SL); bf16_t* MIX = (bf16_t*)(p.ws + O_XN);
    LAS float* Bc = (LAS float*)F.lds;
    LAS float* Qt = Bc + 4096;
    LAS float* Kt = Qt + 64 * 65;
    LAS float* At = Kt + 64 * 65;
    LAS float* Vs = At + 64 * 65;
    LAS float* Ss = Vs + 8192;
    LAS float* Zs = Ss + 8192;
    LAS float* Wg = Zs + 1024;
    LAS float* Seg = Wg + 2 * 17 * 64;
    LAS float* Os = Qt;
    const int l31 = F.lane & 31, lh = F.lane >> 5, it2 = F.wave >> 2, et = F.wave & 3, ita = (F.wave >> 1) & 1, jta = F.wave & 1;
    const int sj = F.tid >> 3, sd8 = (F.tid & 7) * 8;
    constexpr int NU = NCH * 16;
    u32x4 nv[2], nk, nq; f32x4 nz = {0.f, 0.f, 0.f, 0.f}; u32x4 ns[2]; unsigned nrw[8]; int hcur = -1;
#define GLC_LOADMAIN(g_) do { GLA_LOADV(g_); nq = *(const u32x4*)(P + (size_t)((g_).row0 + sj) * PW + (g_).h * 64 + sd8); \
    _Pragma("unroll") for (int q_ = 0; q_ < 8; ++q_) nrw[q_] = *(const unsigned*)(P + (size_t)((g_).row0 + F.wave * 8 + q_) * PW + 1024 + (g_).h * 128 + 2 * F.lane); } while (0)
#define GLC_LOADS(g_, dir_) do { const bf16_t* src_ = SL + sl_off((dir_), (g_).b, (g_).h, (dir_) == 0 ? (g_).pf : (g_).pb); \
    _Pragma("unroll") for (int q_ = 0; q_ < 2; ++q_) ns[q_] = *(const u32x4*)(src_ + 8 * (F.tid + 512 * q_)); } while (0)
#define GLC_PUTS() do { _Pragma("unroll") for (int q_ = 0; q_ < 2; ++q_) { float v_[8]; unpack8(ns[q_], v_); LAS float* d_ = Ss + 8 * (F.tid + 512 * q_); \
    *(LAS f32x4*)d_ = (f32x4){v_[0], v_[1], v_[2], v_[3]}; *(LAS f32x4*)(d_ + 4) = (f32x4){v_[4], v_[5], v_[6], v_[7]}; } } while (0)
    int u = F.bid; if (u < NU) { const GlaUnit g0 = gla_unit(u); GLC_LOADMAIN(g0); GLC_LOADS(g0, 0); }
    for (; u < NU; u += F.G) { const GlaUnit g = gla_unit(u);
        if (g.h != hcur) { GLA_LOADWG(g.h); hcur = g.h; }
        GLA_PUTV(); float qr[8], kr[8]; unpack8(nq, qr); unpack8(nk, kr); unsigned rw[8];
#pragma unroll
        for (int q = 0; q < 8; ++q) rw[q] = nrw[q];
        GLC_PUTS();
        LBAR();
        f32x16 oacc = {};
#pragma unroll
        for (int dir = 0; dir < 2; ++dir) {
            if (dir == 0) GLC_LOADS(g, 1);
            else { GLC_PUTS(); if (u + F.G < NU) { const GlaUnit gn = gla_unit(u + F.G); GLC_LOADMAIN(gn); GLC_LOADS(gn, 0); } }
            gla_cum(F, dir, Bc, Zs, Wg, Seg);
#pragma unroll
            for (int q = 0; q < 8; ++q) { const float bb = Bc[sj * 64 + sd8 + q]; Qt[sj * 65 + sd8 + q] = qr[q] * 0.125f * __expf(bb); Kt[sj * 65 + sd8 + q] = kr[q] * __expf(-bb); }
            LBAR();
            if (F.wave < 4) {
                f32x16 a = {};
                MFMA_K64(a, Qt[(32 * ita + l31) * 65 + k_], Kt[(32 * jta + l31) * 65 + k_]);
#pragma unroll
                for (int r = 0; r < 16; ++r) { const int i = 32 * ita + (r & 3) + 8 * (r >> 2) + 4 * lh, j = 32 * jta + l31; const bool keep = dir == 0 ? (j <= i) : (j >= i);
                    const float v = keep ? a[r] : 0.f; if (dir == 0) At[i * 65 + j] = v; else At[i * 65 + j] += v; }
            }
            MFMA_K64(oacc, Qt[(32 * it2 + l31) * 65 + k_], Ss[k_ * 128 + 32 * et + l31]);
            LBAR();
        }
        MFMA_K64(oacc, At[(32 * it2 + l31) * 65 + k_], Vs[k_ * 128 + 32 * et + l31]);
#pragma unroll
        for (int r = 0; r < 16; ++r) { const int i = 32 * it2 + (r & 3) + 8 * (r >> 2) + 4 * lh; Os[i * 129 + 32 * et + l31] = oacc[r]; }
        LBAR();
        { const int c0 = g.h * 128 + 2 * F.lane; const f32x2 gg = *(const f32x2*)(p.g_gla + c0);
#pragma unroll
          for (int q = 0; q < 8; ++q) { const int i = F.wave * 8 + q, row = g.row0 + i; const float x0 = Os[i * 129 + 2 * F.lane], x1 = Os[i * 129 + 2 * F.lane + 1];
            const float rs = 1.0f / sqrtf(wave_sum(x0 * x0 + x1 * x1) * (1.0f / 128.0f) + EPS);
            const float r0 = bf2f(rw[q] & 0xffffu), r1 = bf2f(rw[q] >> 16);
            *(unsigned*)(MIX + (size_t)row * DM + 512 + c0) = pk2(x0 * rs * gg[0] * silu_f(r0), x1 * rs * gg[1] * silu_f(r1)); } }
        LBAR();
    }
#undef GLC_LOADMAIN
#undef GLC_LOADS
#undef GLC_PUTS
}

__device__ __forceinline__ void dft_combine(const Params& p, const Ctx& F) {
    const bf16_t* PQ = (const bf16_t*)p.out + (size_t)8192 * 2048; const bf16_t* V0 = (const bf16_t*)(p.ws + O_VTF); const bf16_t* V2 = V0 + (size_t)2 * NDC * 2048; bf16_t* MIX = (bf16_t*)(p.ws + O_XN);
    const float sc = 1.0f / sqrtf(8192.0f);
    LAS float* nyq = (LAS float*)F.lds;
    for (int n = F.tid; n < 1040; n += 512) nyq[n] = bf2f(V2[(size_t)n * 2048]);
    __syncthreads();
    for (long it = (long)F.bid * 512 + F.tid; it < (long)4096 * 128; it += (long)F.G * 512) { const int k = (int)(it >> 7), n0 = (int)(it & 127) * 8, bg = n0 >> 6, m0 = n0 & 63, b = bg >> 2, cc = (bg & 3) * 128, par = k & 1, kp = k >> 1;
        float pv[8], qv[8]; unpack8(*(const u32x4*)(PQ + (size_t)(par * 2048 + kp) * NDC + n0), pv); unpack8(*(const u32x4*)(PQ + (size_t)(4096 + par * 2048 + kp) * NDC + n0), qv);
        float f0[8], f1[8]; const float sg = par ? 0.f : ((kp & 1) ? -2.f * sc : 2.f * sc);
#pragma unroll
        for (int e = 0; e < 8; ++e) { f0[e] = pv[e] + qv[e]; f1[e] = pv[e] - qv[e] + sg * nyq[n0 + e]; }
        bf16_t* rk = MIX + (size_t)(b * SEQ + k) * DM + cc; bf16_t* rl = MIX + (size_t)(b * SEQ + (k ? SEQ - k : 0)) * DM + cc;
        u32x4 o; o.x = pk2(f0[0], f0[1]); o.y = pk2(f0[2], f0[3]); o.z = pk2(f0[4], f0[5]); o.w = pk2(f0[6], f0[7]); *(u32x4*)(rk + m0) = o;
        if (k > 0) { u32x4 o1; o1.x = pk2(f1[0], f1[1]); o1.y = pk2(f1[2], f1[3]); o1.z = pk2(f1[4], f1[5]); o1.w = pk2(f1[6], f1[7]); *(u32x4*)(rl + m0) = o1; }
#pragma unroll
        for (int e = 0; e < 8; ++e) { const int m = m0 + e; if (m > 0) { rk[128 - m] = (bf16_t)f2bf(f1[e]); if (k > 0) rl[128 - m] = (bf16_t)f2bf(f0[e]); } } }
    for (long it = (long)F.bid * 512 + F.tid; it < (long)4096 * 16; it += (long)F.G * 512) { const int k = (int)(it >> 4), bg = (int)(it & 15), b = bg >> 2, cc = (bg & 3) * 128 + 64, par = k & 1, kp = k >> 1;
        const float pvv = bf2f(PQ[(size_t)(par * 2048 + kp) * NDC + 1024 + bg]); const float ev = par ? 0.f : ((kp & 1) ? -sc : sc) * nyq[1024 + bg];
        const bf16_t o = (bf16_t)f2bf(pvv + ev); MIX[(size_t)(b * SEQ + k) * DM + cc] = o; if (k > 0) MIX[(size_t)(b * SEQ + SEQ - k) * DM + cc] = o; }
    for (int n = F.gw; n < 1040; n += F.NGW) { const bf16_t* row = V0 + (size_t)n * 2048; float s = 0.f;
#pragma unroll
        for (int q = 0; q < 4; ++q) { float v[8]; unpack8(*(const u32x4*)(row + (q * 64 + F.lane) * 8), v); s += (v[0] - v[1]) + (v[2] - v[3]) + (v[4] - v[5]) + (v[6] - v[7]); }
        s = wave_sum(s);
        if (F.lane == 0) { const int bg = n < 1024 ? (n >> 6) : (n - 1024), m = n < 1024 ? (n & 63) : 64, b = bg >> 2, cc = (bg & 3) * 128; const bf16_t o = (bf16_t)f2bf((s + bf2f(V2[(size_t)n * 2048])) * sc);
            bf16_t* r = MIX + (size_t)(b * SEQ + 4096) * DM + cc; r[m] = o; if (m > 0 && m < 64) r[128 - m] = o; } }
}

__device__ __forceinline__ void rope_pass(const Params& p, const Ctx& F) {
    const bf16_t* QKV = (const bf16_t*)(p.ws + O_QKV); bf16_t* QF = (bf16_t*)(p.ws + O_QF); bf16_t* KALL = (bf16_t*)(p.ws + O_KALL); bf16_t* VALL = (bf16_t*)(p.ws + O_VALL);
    const float* ROPE = (const float*)(p.ws + O_ROPE);
    const int pl = F.lane & 31, half = F.lane >> 5, e0 = half * 64 + 2 * pl;
    for (int row = F.gw; row < MROWS; row += F.NGW) {
        const bool lat = row < NLAT; int b, s, t = 0;
        if (lat) { b = row >> 13; t = row & 8191; s = CTXL + t; } else { b = (row - NLAT) >> 8; s = (row - NLAT) & 255; }
        const int pos = pl < 16 ? (t >> 6) : (t & 63); const f32x4 cs = *(const f32x4*)(ROPE + ((size_t)pos * 32 + 2 * (pl & 15)) * 2);
        const size_t kvo = ((size_t)(b * SKV + s) * 2) * 128;
        unsigned wv[12];
#pragma unroll
        for (int hd = 0; hd < 12; ++hd) wv[hd] = (lat || hd >= 8) ? *(const unsigned*)(QKV + (size_t)row * NQKV + hd * 128 + e0) : 0u;
#pragma unroll
        for (int hd = 0; hd < 12; ++hd) {
            if (!lat && hd < 8) continue;
            const unsigned w = wv[hd];
            if (hd >= 10) { *(unsigned*)(VALL + kvo + (hd - 10) * 128 + e0) = w; continue; }
            float x0 = bf2f(w & 0xffffu), x1 = bf2f(w >> 16);
            const float rs = 1.0f / sqrtf(wave_sum(x0 * x0 + x1 * x1) * (1.0f / 128.0f) + EPS);
            const float* gg = hd < 8 ? p.g_q : p.g_k; x0 *= rs * gg[e0]; x1 *= rs * gg[e0 + 1];
            if (lat) { const float y0 = __shfl_xor(x0, 32), y1 = __shfl_xor(x1, 32); const float sg = half ? 1.f : -1.f;
                x0 = x0 * cs[0] + sg * y0 * cs[1]; x1 = x1 * cs[2] + sg * y1 * cs[3]; }
            const unsigned o = pk2(x0, x1);
            if (hd < 8) *(unsigned*)(QF + (size_t)row * DM + hd * 128 + e0) = o; else *(unsigned*)(KALL + kvo + (hd - 8) * 128 + e0) = o;
        }
    }
}


#define XB_TMO      128
#define XB_XCNT(j)  (256  + 64 * (j))
#define XB_XSUB(j)  (1280 + 64 * (j))
#define XB_XGEN(j)  (2304 + 64 * (j))
#define XB_TOP      3328
#define XB_TOPGEN   3392
#define XCD_BAR_WORDS 3456
#define XB_SPIN_CAP (1u << 20)
__device__ __forceinline__ unsigned xb_ld(unsigned* p)              { return __hip_atomic_load(p, __ATOMIC_RELAXED, __HIP_MEMORY_SCOPE_AGENT); }
__device__ __forceinline__ unsigned xb_add(unsigned* p, unsigned v) { return __hip_atomic_fetch_add(p, v, __ATOMIC_RELAXED, __HIP_MEMORY_SCOPE_AGENT); }
__device__ __forceinline__ unsigned xb_xcc_id() { return (unsigned)__builtin_amdgcn_s_getreg((3 << 11) | 20) & 0xFu; }
#define XB_SPIN(cond, bar) do { unsigned _sp = 0; while (cond) { __builtin_amdgcn_s_sleep(1); \
    if ((++_sp & 255u) == 0u) { if (xb_ld(&(bar)[XB_TMO])) break; if (_sp > XB_SPIN_CAP) { atomicAdd(&(bar)[XB_TMO], 1u); break; } } } } while (0)
struct XcdBarrier { unsigned* bar; unsigned x; volatile LAS unsigned* st; };
__device__ __forceinline__ void xcd_barrier_complete(unsigned* bar, unsigned x, unsigned& nloc, unsigned& nx) {
    const unsigned G = gridDim.x * gridDim.y * gridDim.z;
    unsigned sum, cnt, mine, sp = 0u;
    for (;;) {
        sum = 0u; cnt = 0u; mine = 0u;
#pragma unroll
        for (unsigned j = 0; j < 16; ++j) { const unsigned c = xb_ld(&bar[XB_XCNT(j)]); sum += c; cnt += (c > 0u) ? 1u : 0u; mine = (j == x) ? c : mine; }
        if (sum == G) break;
        __builtin_amdgcn_s_sleep(1);
        if ((++sp & 255u) == 0u) { if (xb_ld(&bar[XB_TMO])) break; if (sp > XB_SPIN_CAP) { atomicAdd(&bar[XB_TMO], 1u); break; } }
    }
    nloc = mine > 0u ? mine : 1u; nx = cnt > 0u ? cnt : 1u;
}
__device__ __forceinline__ void xcd_barrier(const XcdBarrier& b) {
    asm volatile("s_waitcnt vmcnt(0)" ::: "memory");
    __syncthreads();
    if (threadIdx.x == 0) {
        unsigned* bar = b.bar;
        __builtin_amdgcn_s_waitcnt(0);
        unsigned nloc = b.st[0], nx = b.st[1];
        if (nloc == 0u) { xcd_barrier_complete(bar, b.x, nloc, nx); b.st[0] = nloc; b.st[1] = nx; }
        const unsigned old = xb_add(&bar[XB_XSUB(b.x)], 1u);
        const unsigned gen = old / nloc;
        if (old + 1u == (gen + 1u) * nloc) {
            __builtin_amdgcn_fence(__ATOMIC_RELEASE, "agent");
            asm volatile("s_waitcnt vmcnt(0)" ::: "memory");
            const unsigned og = xb_add(&bar[XB_TOP], 1u);
            const unsigned tg = og / nx;
            if (og + 1u == (tg + 1u) * nx) xb_add(&bar[XB_TOPGEN], 1u);
            else XB_SPIN(xb_ld(&bar[XB_TOPGEN]) == tg, bar);
            __builtin_amdgcn_fence(__ATOMIC_ACQUIRE, "agent");
            xb_add(&bar[XB_XGEN(b.x)], 1u);
            asm volatile("s_waitcnt vmcnt(0)" ::: "memory");
        } else {
            XB_SPIN(xb_ld(&bar[XB_XGEN(b.x)]) == gen, bar);
            __builtin_amdgcn_fence(__ATOMIC_ACQUIRE, "agent");
            asm volatile("s_waitcnt vmcnt(0)" ::: "memory");
        }
    }
    __syncthreads();
}
constexpr size_t O_BAR = 512 * 1024;
constexpr int BARST_OFF = LDS_BYTES - 64;
#ifndef DUPMASK
#define DUPMASK 0u
#endif
#define REP(n) for (int rep_ = 0; rep_ < (((DUPMASK) >> (n)) & 1u ? 2 : 1); ++rep_)
#ifdef ONLY
#define PHSEL(n) ((n) == ONLY)
#else
#define PHSEL(n) true
#endif
typedef const __attribute__((address_space(4))) Params* KParams;
#if defined(__HIP_DEVICE_COMPILE__)
#define PH_LOADP KParams kp_ = (KParams)__builtin_amdgcn_kernarg_segment_ptr(); asm volatile("" : "+s"(kp_)); const Params p = *kp_;
#else
#define PH_LOADP const Params p = p_arg;
#endif
#define PH_BEGIN PH_LOADP \
    Ctx F; { int t_ = threadIdx.x; asm volatile("" : "+v"(t_)); int b_ = blockIdx.x, g_ = gridDim.x; asm volatile("" : "+s"(b_), "+s"(g_)); \
      F.tid = t_; F.lane = t_ & 63; F.wave = __builtin_amdgcn_readfirstlane(t_ >> 6); F.G = g_; F.bid = b_; F.gw = b_ * 8 + F.wave; F.NGW = g_ * 8; F.lds = (LAS unsigned char*)lds_raw; } \
    unsigned char* ws = p.ws; float* MODV = (float*)(ws + O_MODV); bf16_t* HB = (bf16_t*)(ws + O_HB); bf16_t* XN = (bf16_t*)(ws + O_XN); const float* MOD1 = MODV + 5 * 6144; \
    const long gtid = (long)F.bid * 512 + F.tid, nth = (long)F.G * 512; (void)MODV; (void)HB; (void)XN; (void)MOD1; (void)gtid; (void)nth;
#define GBAR() do { PH_LOADP XcdBarrier b_; b_.bar = (unsigned*)(p.ws + O_BAR); b_.x = xb_xcc_id(); b_.st = (volatile LAS unsigned*)((LAS unsigned char*)lds_raw + BARST_OFF); xcd_barrier(b_); } while (0)
__global__ void __launch_bounds__(512) fwd_mega(Params p_arg) {
    extern __shared__ __attribute__((aligned(16))) unsigned char lds_raw[];
    cg::grid_group grid = cg::this_grid();
    { PH_LOADP
      if (threadIdx.x < 2) ((LAS unsigned*)((LAS unsigned char*)lds_raw + BARST_OFF))[threadIdx.x] = 0u;
      if (threadIdx.x == 0) (void)xb_add(&((unsigned*)(p.ws + O_BAR))[XB_XCNT(xb_xcc_id())], 1u);
      __syncthreads(); }

    if constexpr (PHSEL(0)) { PH_BEGIN REP(0) {
    phase0(p, F);
    } }
    GBAR();
    if (p_arg.ws == nullptr) grid.sync();
    if constexpr (PHSEL(1)) { PH_BEGIN REP(1) {
    phase0b(p, F);
    } }
    GBAR();
    if constexpr (PHSEL(2)) { PH_BEGIN REP(2) {
    normmod(F, p.x, p.ctx, p.g_mix, MODV, 0, 1, XN, MROWS);
    } }
    GBAR();
    if constexpr (PHSEL(3)) { PH_BEGIN REP(3) {
    { pg8::Gemm g{XN, (const bf16_t*)(ws + O_WIN), DM}; pg8::StaticOrder S; S.init(MROWS / 256, NINP / 256, F.G, F.bid);
      pg8::EpiIn E{(bf16_t*)(ws + O_VT), (bf16_t*)(ws + O_VTC), (bf16_t*)(ws + O_P), (float*)(ws + O_Z)};
      pg8::gemm_phase<pg8::EpiIn, false>(F.lds, g, S, E, F.tid); }
    } }
    GBAR();
    if constexpr (PHSEL(4)) { PH_BEGIN REP(4) {
    gla_passA(p, F);
    fold4_pass((const bf16_t*)(ws + O_VT), (bf16_t*)(ws + O_VTF), gtid, nth);
    fold_pass((const bf16_t*)(ws + O_VTC), (bf16_t*)(ws + O_VTCF), CTXL, (size_t)128, 256, gtid, nth);
    } }
    GBAR();
    if constexpr (PHSEL(5)) { PH_BEGIN REP(5) {
    gla_passB(p, F);
    { pg8::Gemm g{(const bf16_t*)p.out, (const bf16_t*)(ws + O_VTF), 2048, 3, (size_t)NDC * 2048 * 2}; pg8::StaticOrder S; S.init(32, 4, F.G, F.bid); S.xn = 16; S.xpm0 = 0; S.xpn0 = 4; S.xcols = 1;
      pg8::EpiBf E{(bf16_t*)p.out + (size_t)8192 * 2048, NDC}; pg8::gemm_phase<pg8::EpiBf, false>(F.lds, g, S, E, F.tid); }
    { pg8::Gemm g{(const bf16_t*)(ws + O_DFTC), (const bf16_t*)(ws + O_VTCF), CTXL}; pg8::StaticOrder S; S.init(1, 2048 / 256, F.G, F.G >= 160 ? (F.bid + F.G - 144) % F.G : F.bid);
      pg8::EpiDft E{XN, NLAT, CTXL}; pg8::gemm_phase<pg8::EpiDft, false>(F.lds, g, S, E, F.tid); }
    } }
    GBAR();
    if constexpr (PHSEL(6)) { PH_BEGIN REP(6) {
    gla_passC(p, F);
    dft_combine(p, F);
    } }
    GBAR();
    if constexpr (PHSEL(7)) { PH_BEGIN REP(7) {
    { pg8::Gemm g{XN, (const bf16_t*)(ws + O_WOUT), DM}; pg8::StaticOrder S; S.init(MROWS / 256, 4, F.G, F.bid);
      pg8::EpiResB E{p.x, p.ctx, nullptr, HB, MODV + 2 * DM}; pg8::gemm_phase<pg8::EpiResB, false>(F.lds, g, S, E, F.tid); }
    } }
    GBAR();
    if constexpr (PHSEL(8)) { PH_BEGIN REP(8) {
    normmod_b(F, HB, p.g_ffn, MODV, 3, 4, XN, MROWS);
    } }
    GBAR();
    if constexpr (PHSEL(9)) { PH_BEGIN REP(9) {
    { pg8::Gemm g{XN, (const bf16_t*)(ws + O_WUP), DM}; pg8::StaticOrder S; S.init((MROWS + 247) / 248, NUP / 256, F.G, F.bid);
      pg8::EpiUp E{(bf16_t*)(ws + O_GH), p.w_conv, p.b_conv, MROWS}; pg8::gemm_phase<pg8::EpiUp, true>(F.lds, g, S, E, F.tid); }
    } }
    GBAR();
    if constexpr (PHSEL(10)) { PH_BEGIN REP(10) {
    { pg8::Gemm g{(const bf16_t*)(ws + O_GH), (const bf16_t*)(ws + O_WDN), DFF}; pg8::StaticOrder S; S.init(MROWS / 256, 4, F.G, F.bid);
      pg8::EpiResB E{nullptr, nullptr, HB, HB, MODV + 5 * DM}; pg8::gemm_phase<pg8::EpiResB, false>(F.lds, g, S, E, F.tid); }
    } }
    GBAR();
    if constexpr (PHSEL(11)) { PH_BEGIN REP(11) {
    normmod_b(F, HB, p.g_mix + DM, MOD1, 0, 1, XN, MROWS);
    } }
    GBAR();
    if constexpr (PHSEL(12)) { PH_BEGIN REP(12) {
    { pg8::Gemm g{XN, (const bf16_t*)(ws + O_WQKV), DM}; pg8::StaticOrder S; S.init(NLAT / 256, NQKV / 256, F.G, F.bid); S.xn = 8; S.xpm0 = NLAT / 256; S.xpn0 = 4; S.xcols = 2;
      pg8::EpiBf E{(bf16_t*)(ws + O_QKV), NQKV}; pg8::gemm_phase<pg8::EpiBf, false>(F.lds, g, S, E, F.tid); }
    } }
    GBAR();
    if constexpr (PHSEL(13)) { PH_BEGIN REP(13) {
    rope_pass(p, F);
    } }
    GBAR();
    if constexpr (PHSEL(14)) { PH_BEGIN REP(14) {
    { const bf16_t* QF = (const bf16_t*)(ws + O_QF); const bf16_t* KALL = (const bf16_t*)(ws + O_KALL); const bf16_t* VALL = (const bf16_t*)(ws + O_VALL); bf16_t* ATTO = (bf16_t*)(ws + O_ATTO);
      for (int u = F.bid; u < 1024; u += F.G) { const int b = u >> 8, r = u & 255, h = r & 7, qb = r >> 3;
          const size_t qo = (size_t)(b * SEQ + qb * 256) * DM + h * 128, ko = (size_t)b * SKV * 256 + (h >> 2) * 128;
          att::attn_dense_body(QF + qo, KALL + ko, VALL + ko, ATTO + qo, SKV, (char*)lds_raw, F.tid);
          __syncthreads(); } }
    } }
    GBAR();
    if constexpr (PHSEL(15)) { PH_BEGIN REP(15) {
    { pg8::Gemm g{(const bf16_t*)(ws + O_ATTO), (const bf16_t*)(ws + O_WATT), DM}; pg8::StaticOrder S; S.init(NLAT / 256, 4, F.G, F.bid);
      pg8::EpiResB E{nullptr, nullptr, HB, HB, MOD1 + 2 * DM}; pg8::gemm_phase<pg8::EpiResB, false>(F.lds, g, S, E, F.tid); }
    } }
    GBAR();
    if constexpr (PHSEL(16)) { PH_BEGIN REP(16) {
    normmod_b(F, HB, p.g_ffn + DM, MOD1, 3, 4, XN, NLAT);
    } }
    GBAR();
    if constexpr (PHSEL(17)) { PH_BEGIN REP(17) {
    { pg8::Gemm g{XN, (const bf16_t*)(ws + O_WUP) + (size_t)NUP * DM, DM}; pg8::StaticOrder S; S.init((NLAT + 247) / 248, NUP / 256, F.G, F.bid);
      pg8::EpiUp E{(bf16_t*)(ws + O_GH), p.w_conv + 3 * NUP, p.b_conv + NUP, NLAT}; pg8::gemm_phase<pg8::EpiUp, true>(F.lds, g, S, E, F.tid); }
    } }
    GBAR();
    if constexpr (PHSEL(18)) { PH_BEGIN REP(18) {
    { pg8::Gemm g{(const bf16_t*)(ws + O_GH), (const bf16_t*)(ws + O_WDN) + (size_t)DM * DFF, DFF}; pg8::StaticOrder S; S.init(NLAT / 256, 4, F.G, F.bid);
      pg8::EpiResB E{nullptr, nullptr, HB, HB, MOD1 + 5 * DM}; pg8::gemm_phase<pg8::EpiResB, false>(F.lds, g, S, E, F.tid); }
    } }
    GBAR();
    if constexpr (PHSEL(19)) { PH_BEGIN REP(19) {
    for (int row0 = F.gw; row0 < NLAT; row0 += 4 * F.NGW) {
        u32x4 w[4][2];
#pragma unroll
        for (int q = 0; q < 4; ++q) { const int row = row0 + q * F.NGW; if (row < NLAT) {
#pragma unroll
            for (int j = 0; j < 2; ++j) w[q][j] = *(const u32x4*)(HB + (size_t)row * DM + 512 * j + 8 * F.lane); } }
#pragma unroll
        for (int q = 0; q < 4; ++q) { const int row = row0 + q * F.NGW; if (row < NLAT) { float v[2][8]; float ss = 0.f;
#pragma unroll
            for (int j = 0; j < 2; ++j) { unpack8(w[q][j], v[j]);
#pragma unroll
                for (int e2 = 0; e2 < 8; ++e2) ss += v[j][e2] * v[j][e2]; }
            const float rs = 1.0f / sqrtf(wave_sum(ss) * (1.0f / DM) + EPS);
#pragma unroll
            for (int j = 0; j < 2; ++j) { const int col = 512 * j + 8 * F.lane;
#pragma unroll
                for (int q2 = 0; q2 < 2; ++q2) { const f32x4 gg = *(const f32x4*)(p.g_final + col + 4 * q2); f32x4 y;
#pragma unroll
                    for (int e2 = 0; e2 < 4; ++e2) y[e2] = v[j][4 * q2 + e2] * rs * gg[e2];
                    *(f32x4*)(p.out + (size_t)row * DM + col + 4 * q2) = y; } } } } }
    } }
}

extern "C" void kernel_launch(void* const* d_in, const int* in_sizes, int n_in, void* d_out, int out_size, void* d_ws, size_t ws_size, hipStream_t stream) {
    static int grid = 0;
    if (grid == 0) {
        if (n_in != 22 || out_size != NLAT * DM || ws_size < WS_NEED) { fprintf(stderr, "kernel_launch: unexpected shapes n_in %d out %d ws %zu\n", n_in, out_size, ws_size); grid = -1; return; }
        int dev = 0, cus = 0, per_cu = 0;
        hipGetDevice(&dev); hipDeviceGetAttribute(&cus, hipDeviceAttributeMultiprocessorCount, dev);
        if (hipFuncSetAttribute((const void*)fwd_mega, hipFuncAttributeMaxDynamicSharedMemorySize, LDS_BYTES) != hipSuccess) { fprintf(stderr, "kernel_launch: hipFuncSetAttribute failed\n"); grid = -1; return; }
        if (hipOccupancyMaxActiveBlocksPerMultiprocessor(&per_cu, (const void*)fwd_mega, 512, LDS_BYTES) != hipSuccess || per_cu < 1) { fprintf(stderr, "kernel_launch: occupancy query gave %d\n", per_cu); per_cu = 1; }
        (void)hipGetLastError();
        grid = cus * (per_cu > 1 ? 1 : per_cu);
    }
    if (grid < 0) return;
    Params p{};
    const float** pp = (const float**)&p;
    for (int i = 0; i < 22; ++i) pp[i] = (const float*)d_in[i];
    p.out = (float*)d_out; p.ws = (unsigned char*)d_ws;
    if (hipMemsetAsync((char*)d_ws + O_BAR, 0, 16384, stream) != hipSuccess) { fprintf(stderr, "kernel_launch: memset failed\n"); return; }
    void* args[] = {&p};
    hipError_t e = hipLaunchCooperativeKernel((const void*)fwd_mega, dim3(grid), dim3(512), args, LDS_BYTES, stream);
    if (e != hipSuccess) fprintf(stderr, "cooperative launch failed: %s (grid %d)\n", hipGetErrorString(e), grid);
}
```

```cpp
#include <hip/hip_runtime.h>
#include <hip/hip_cooperative_groups.h>
#include <cstdio>
#include <cstdint>
namespace cg = cooperative_groups;

#define LAS __attribute__((address_space(3)))
typedef unsigned short bf16_t;
typedef short bf16x8 __attribute__((ext_vector_type(8)));
typedef short s16x4 __attribute__((ext_vector_type(4)));
typedef float f32x4 __attribute__((ext_vector_type(4)));
typedef float f32x2 __attribute__((ext_vector_type(2)));
typedef float f32x16 __attribute__((ext_vector_type(16)));
typedef unsigned u32x4 __attribute__((ext_vector_type(4)));
typedef unsigned u32x2 __attribute__((ext_vector_type(2)));

constexpr int DM = 1024, NB = 4, SEQ = 8192, CTXL = 256;
constexpr int NLAT = NB * SEQ, NCTX = NB * CTXL, MROWS = NLAT + NCTX;
constexpr int DFF = 2816, NUP = 5632, NIN = 2064, NINP = 2304, PW = 1792, NQKV = 1536;
constexpr int NDC = 1280;
constexpr int NCH = 132;
constexpr float EPS = 1e-6f;
constexpr int SKV = CTXL + SEQ;

constexpr size_t MiB = 1u << 20;
constexpr size_t O_MODV = 0, O_PART = 1 * MiB, O_COST = 9 * MiB, O_ROPE = 9 * MiB + 65536, O_DFTC = 9 * MiB + 262144;
constexpr size_t O_Z = 10 * MiB, O_HCTX = 13 * MiB, O_DEC = 17 * MiB;
constexpr size_t O_WIN = 20 * MiB, O_WOUT = 26 * MiB, O_WQKV = 28 * MiB, O_WATT = 31 * MiB, O_WUP = 33 * MiB, O_WDN = 55 * MiB;
constexpr size_t O_XN = 68 * MiB;
constexpr size_t O_P = 135 * MiB;
constexpr size_t O_VT = 251 * MiB, O_VTC = 315 * MiB;
constexpr size_t O_VTF = 317 * MiB, O_VTCF = 349 * MiB;
constexpr size_t O_SL = 350 * MiB;
constexpr size_t O_GH = 135 * MiB;
constexpr size_t O_QKV = 135 * MiB, O_QF = 234 * MiB, O_KALL = 298 * MiB, O_VALL = 315 * MiB, O_ATTO = 416 * MiB;
constexpr size_t O_HB = 350 * MiB;
constexpr size_t WS_NEED = 482 * MiB;
constexpr int LDS_BYTES = 147456;

__device__ __forceinline__ unsigned f2bf(float f) { unsigned u = __builtin_bit_cast(unsigned, f); return (u + 0x7fffu + ((u >> 16) & 1u)) >> 16; }
__device__ __forceinline__ unsigned pk2(float lo, float hi) { return f2bf(lo) | (f2bf(hi) << 16); }
__device__ __forceinline__ float bf2f(unsigned b) { return __builtin_bit_cast(float, b << 16); }
__device__ __forceinline__ void unpack8(const u32x4 w, float* o) { o[0] = bf2f(w.x & 0xffffu); o[1] = bf2f(w.x >> 16); o[2] = bf2f(w.y & 0xffffu); o[3] = bf2f(w.y >> 16); o[4] = bf2f(w.z & 0xffffu); o[5] = bf2f(w.z >> 16); o[6] = bf2f(w.w & 0xffffu); o[7] = bf2f(w.w >> 16); }
__device__ __forceinline__ float wave_sum(float v) {
#pragma unroll
    for (int o = 1; o < 64; o <<= 1) v += __shfl_xor(v, o);
    return v;
}
__device__ __forceinline__ float silu_f(float x) { return x * __builtin_amdgcn_rcpf(1.0f + __expf(-x)); }
#define LDS_WAIT() asm volatile("s_waitcnt lgkmcnt(0)" ::: "memory")

namespace pg8 {
constexpr int BM = 256, BK = 64, HALF = 128, HTB = HALF * BK * 2, STAGE_BYTES = 8 * HTB, NXCD = 8, WGM = 4;
__host__ __device__ __forceinline__ int lds_byte(int r, int c) { const int st = (r >> 4) * 2 + (c >> 5), rr = r & 15, cc = c & 31, ob = rr * 64 + cc * 2; return st * 1024 + (ob ^ (((ob >> 9) & 1) << 5)); }
__host__ __device__ __forceinline__ void stage_rc(int b, int& R, int& C) { const int st = b / 1024, sb = b % 1024, swz = sb ^ (((sb >> 9) & 1) << 5); R = (st >> 1) * 16 + swz / 64; C = (st & 1) * 32 + (swz % 64) / 2; }
__host__ __device__ __forceinline__ int perm32(int rho) { const int n = rho >> 4, i = rho & 15; return 8 * (i >> 2) + 4 * n + (i & 3); }
struct Unit { int pm, pn; };
struct Gemm { const bf16_t* A; const bf16_t* Bt; int K; int bsh = 30; size_t bstr = 0; };
struct StaticOrder {
    int nM, nN, nwg, G, c;
    int xn = 0, xpm0 = 0, xpn0 = 0, xcols = 1;
    __device__ void init(int nM_, int nN_, int G_, int c_) { nM = nM_; nN = nN_; nwg = nM * nN; G = G_; c = c_; }
    __device__ bool next(int i, Unit& u) const {
        const long L = (long)i * G + c; if (L >= nwg + xn) return false;
        if (L >= nwg) { const int e = (int)L - nwg; u.pm = xpm0 + e / xcols; u.pn = xpn0 + e % xcols; return true; }
        int wgid = (int)L; { const int q = nwg / NXCD, r = nwg % NXCD, xcd = wgid % NXCD, off = wgid / NXCD; wgid = (xcd < r ? xcd * (q + 1) : r * (q + 1) + (xcd - r) * q) + off; }
        const int nig = WGM * nN, gid = wgid / nig, fm = gid * WGM, gsz = (nM - fm) < WGM ? (nM - fm) : WGM;
        u.pm = fm + ((wgid % nig) % gsz); u.pn = (wgid % nig) / gsz; return true;
    }
};
__device__ __forceinline__ unsigned cvt_pk_bf16(float lo, float hi) { unsigned r; asm volatile("v_cvt_pk_bf16_f32 %0, %1, %2" : "=v"(r) : "v"(lo), "v"(hi)); return r; }

template <class Epi, bool CONV>
__device__ __forceinline__ void gemm_phase(LAS unsigned char* lds, const Gemm g, const StaticOrder& S, const Epi& E, const int tid) {
    const int wid = __builtin_amdgcn_readfirstlane(tid >> 6), lane = tid & 63, wr = wid >> 2, wc = wid & 3, fr = lane & 15, fq = lane >> 4;
    const int K = g.K, nt = K / BK;
    int voffA[2], voffB[2];
#pragma unroll
    for (int i = 0; i < 2; ++i) { int R, C; stage_rc(tid * 16 + i * 8192, R, C); const int Rb = Epi::PERM ? ((R & ~31) + perm32(R & 31)) : R;
        const int Ra = CONV ? (62 * (R >> 6) - 1 + (R & 63)) : R;
        voffA[i] = (Ra * K + C) * 2; voffB[i] = (Rb * K + C) * 2; }
    const size_t kstep = (size_t)(BK * 2);
    const size_t hsB = (size_t)HALF * K * 2, tsB = 2 * hsB;
    const size_t hsA = CONV ? (size_t)124 * K * 2 : hsB, tsA = 2 * hsA;
    const unsigned ldsw = (unsigned)wid * 1024u;
    const int aoff = lds_byte(wr * 64 + fr, fq * 8), boff = lds_byte(wc * 32 + fr, fq * 8);
#define PG8_SA(b, h) (((b) * 2 + (h)) * HTB)
#define PG8_SB(b, h) ((4 + (b) * 2 + (h)) * HTB)
#define PG8_STAGE(bufoff, gbase, voff) do { _Pragma("unroll") for (int _i = 0; _i < 2; ++_i) \
        __builtin_amdgcn_global_load_lds((const unsigned*)((const char*)(gbase) + (voff)[_i]), (LAS unsigned*)(lds + (bufoff) + ldsw + _i * 8192), 16, 0, 0); } while (0)
#define PG8_LDA(dst, b, h) do { _Pragma("unroll") for (int m = 0; m < 4; ++m) _Pragma("unroll") for (int k = 0; k < 2; ++k) dst[m][k] = *(const LAS bf16x8*)(lds + PG8_SA(b, h) + aoff + m * 2048 + k * 1024); } while (0)
#define PG8_LDB(dst, b, h) do { _Pragma("unroll") for (int n = 0; n < 2; ++n) _Pragma("unroll") for (int k = 0; k < 2; ++k) dst[n][k] = *(const LAS bf16x8*)(lds + PG8_SB(b, h) + boff + n * 2048 + k * 1024); } while (0)
#define PG8_MMA(ai, bj, At, Bt) do { __builtin_amdgcn_s_setprio(1); _Pragma("unroll") for (int m = 0; m < 4; ++m) _Pragma("unroll") for (int n = 0; n < 2; ++n) _Pragma("unroll") for (int k = 0; k < 2; ++k) \
        acc[ai][bj][m][n] = __builtin_amdgcn_mfma_f32_16x16x32_bf16(Bt[n][k], At[m][k], acc[ai][bj][m][n], 0, 0, 0); __builtin_amdgcn_s_setprio(0); } while (0)
#define PG8_WAIT_V(n) asm volatile("s_waitcnt vmcnt(" #n ")" ::: "memory")
#define PG8_WAIT_L(n) asm volatile("s_waitcnt lgkmcnt(" #n ")" ::: "memory")
#define PG8_BAR __builtin_amdgcn_s_barrier()
#define PG8_SCHED __builtin_amdgcn_sched_barrier(0)
    Unit cur, nxt; int ui = 0;
    if (!S.next(0, cur)) return;
    f32x4 acc[2][2][4][2];
#pragma unroll
    for (int a = 0; a < 2; ++a)
#pragma unroll
        for (int b = 0; b < 2; ++b)
#pragma unroll
            for (int m = 0; m < 4; ++m)
#pragma unroll
                for (int n = 0; n < 2; ++n) acc[a][b][m][n] = (f32x4){0.f, 0.f, 0.f, 0.f};
    bf16x8 At[4][2], B0[2][2], B1[2][2];
    const char* cA = (const char*)g.A + (size_t)cur.pm * tsA; const char* cB = (const char*)g.Bt + (size_t)cur.pn * tsB + (size_t)(cur.pm >> g.bsh) * g.bstr;
    PG8_STAGE(PG8_SB(0, 0), cB, voffB); PG8_STAGE(PG8_SB(0, 1), cB + hsB, voffB); PG8_STAGE(PG8_SA(0, 0), cA, voffA); PG8_STAGE(PG8_SA(0, 1), cA + hsA, voffA);
    if (wr == 1) PG8_BAR;
    PG8_WAIT_V(2); PG8_BAR;
    PG8_STAGE(PG8_SB(1, 0), cB + kstep, voffB); PG8_STAGE(PG8_SA(1, 0), cA + kstep, voffA); PG8_STAGE(PG8_SB(1, 1), cB + hsB + kstep, voffB);
    PG8_WAIT_V(6); PG8_BAR;
    for (;;) {
        const bool has_next = S.next(ui + 1, nxt);
        const char* nA = has_next ? (const char*)g.A + (size_t)nxt.pm * tsA : cA; const char* nB = has_next ? (const char*)g.Bt + (size_t)nxt.pn * tsB + (size_t)(nxt.pm >> g.bsh) * g.bstr : cB;
        for (int t = 0; t < nt; t += 2) {
            const bool last = (t == nt - 2);
            const char* a1 = cA + (size_t)(t + 1) * kstep;
            const char* a2 = last ? nA : cA + (size_t)(t + 2) * kstep; const char* b2 = last ? nB : cB + (size_t)(t + 2) * kstep;
            const char* a3 = a2 + kstep; const char* b3 = b2 + kstep;
            PG8_LDB(B0, 0, 0); PG8_LDB(B1, 0, 1); PG8_SCHED; PG8_LDA(At, 0, 0); PG8_STAGE(PG8_SA(1, 1), a1 + hsA, voffA);
            PG8_WAIT_V(8); PG8_WAIT_L(0); PG8_BAR; PG8_MMA(0, 0, At, B0); PG8_MMA(0, 1, At, B1); PG8_BAR; PG8_SCHED;
            PG8_LDA(At, 0, 1); PG8_STAGE(PG8_SB(0, 0), b2, voffB); PG8_STAGE(PG8_SB(0, 1), b2 + hsB, voffB); PG8_STAGE(PG8_SA(0, 0), a2, voffA);
            PG8_WAIT_V(8); PG8_WAIT_L(0); PG8_BAR; PG8_MMA(1, 0, At, B0); PG8_MMA(1, 1, At, B1); PG8_BAR; PG8_SCHED;
            PG8_LDB(B0, 1, 0); PG8_LDB(B1, 1, 1); PG8_SCHED; PG8_LDA(At, 1, 0); PG8_STAGE(PG8_SA(0, 1), a2 + hsA, voffA);
            PG8_WAIT_V(8); PG8_WAIT_L(0); PG8_BAR; PG8_MMA(0, 0, At, B0); PG8_MMA(0, 1, At, B1); PG8_BAR; PG8_SCHED;
            PG8_LDA(At, 1, 1); PG8_STAGE(PG8_SB(1, 0), b3, voffB); PG8_STAGE(PG8_SB(1, 1), b3 + hsB, voffB); PG8_STAGE(PG8_SA(1, 0), a3, voffA);
            PG8_WAIT_V(8); PG8_WAIT_L(0); PG8_BAR; PG8_MMA(1, 0, At, B0); PG8_MMA(1, 1, At, B1); PG8_BAR; PG8_SCHED;
        }
        if (wr == 0) PG8_BAR;
        E(acc, cur, wr, wc, fr, fq);
        if (!has_next) break;
#pragma unroll
        for (int a = 0; a < 2; ++a)
#pragma unroll
            for (int b = 0; b < 2; ++b)
#pragma unroll
                for (int m = 0; m < 4; ++m)
#pragma unroll
                    for (int n = 0; n < 2; ++n) acc[a][b][m][n] = (f32x4){0.f, 0.f, 0.f, 0.f};
        cur = nxt; cA = nA; cB = nB; ++ui;
        if (wr == 1) PG8_BAR;
    }
    PG8_WAIT_V(0);
    PG8_BAR;
#undef PG8_SA
#undef PG8_SB
#undef PG8_STAGE
#undef PG8_LDA
#undef PG8_LDB
#undef PG8_MMA
#undef PG8_WAIT_V
#undef PG8_WAIT_L
#undef PG8_BAR
#undef PG8_SCHED
}

typedef f32x4 Acc[2][2][4][2];
struct EpiIn {
    static constexpr bool PERM = true;
    bf16_t* VT; bf16_t* VTC; bf16_t* P; float* Z;
    __device__ __forceinline__ void operator()(const Acc& acc, const Unit& u, int wr, int wc, int fr_, int fq_) const {
        int fr = fr_, fq = fq_; asm volatile("" : "+v"(fr), "+v"(fq));
        const int row0 = u.pm * BM + wr * 64 + fr;
        if (u.pn < 2) {
            const int part = wc >> 1;
#pragma unroll
            for (int ai = 0; ai < 2; ++ai)
#pragma unroll
                for (int m = 0; m < 4; ++m) {
                    const int r = row0 + ai * HALF + m * 16; bf16_t* base; size_t rs; int poff, bb;
                    if (r < NLAT) { bb = r >> 13; const int t = r & 8191; base = VT + t; rs = 16384; poff = 8192; }
                    else { const int r2 = r - NLAT; bb = r2 >> 8; const int s = r2 & 255; base = VTC + s; rs = 512; poff = 256; }
#pragma unroll
                    for (int bj = 0; bj < 2; ++bj) { bf16_t* gb = base + ((size_t)(bb * 4 + 2 * u.pn + bj) * 128) * rs + part * poff;
#pragma unroll
                        for (int n = 0; n < 2; ++n)
#pragma unroll
                            for (int j = 0; j < 4; ++j) { const int mm = 32 * (wc & 1) + 8 * fq + 4 * n + j; const unsigned v = f2bf(acc[ai][bj][m][n][j]);
                                gb[(size_t)mm * rs] = (bf16_t)v; if (mm) gb[(size_t)(128 - mm) * rs] = (bf16_t)(part ? (v ^ 0x8000u) : v); } }
                }
        } else {
            const int colb = (u.pn - 2) * BM + wc * 32 + 8 * fq;
#pragma unroll
            for (int ai = 0; ai < 2; ++ai)
#pragma unroll
                for (int m = 0; m < 4; ++m) {
                    const int r = row0 + ai * HALF + m * 16; bf16_t* rowp = P + (size_t)r * PW + colb;
#pragma unroll
                    for (int bj = 0; bj < 2; ++bj) { if (u.pn == 8 && (bj == 1 || wc >= 2)) continue;
                        const f32x4 v0 = acc[ai][bj][m][0], v1 = acc[ai][bj][m][1];
                        u32x4 w; w.x = cvt_pk_bf16(v0[0], v0[1]); w.y = cvt_pk_bf16(v0[2], v0[3]); w.z = cvt_pk_bf16(v1[0], v1[1]); w.w = cvt_pk_bf16(v1[2], v1[3]);
                        *(u32x4*)(rowp + bj * HALF) = w; }
                    if (u.pn == 8 && wc == 0 && fq < 2) { float* zp = Z + (size_t)r * 16 + 8 * fq; *(f32x4*)zp = acc[ai][0][m][0]; *(f32x4*)(zp + 4) = acc[ai][0][m][1]; }
                    if (u.pn == 8 && wc == 1 && fq == 0) {
                        bf16_t* base; size_t rs; int poff, bb;
                        if (r < NLAT) { bb = r >> 13; base = VT + (r & 8191); rs = 16384; poff = 8192; } else { const int r2 = r - NLAT; bb = r2 >> 8; base = VTC + (r2 & 255); rs = 512; poff = 256; }
#pragma unroll
                        for (int j = 0; j < 4; ++j) { bf16_t* q = base + ((size_t)(bb * 4 + j) * 128 + 64) * rs; q[0] = (bf16_t)f2bf(acc[ai][0][m][0][j]); q[poff] = (bf16_t)0; } }
                }
        }
    }
};
struct EpiResB {
    static constexpr bool PERM = true;
    const float* hin32_lat; const float* hin32_ctx; const bf16_t* hin; bf16_t* out; const float* gate;
    __device__ __forceinline__ void operator()(const Acc& acc, const Unit& u, int wr, int wc, int fr, int fq) const {
        const int row0 = u.pm * BM + wr * 64 + fr, col0 = u.pn * BM + wc * 32 + 8 * fq;
        const int bi = u.pm < 128 ? (u.pm >> 5) : 4;
        f32x4 gv[2][2];
#pragma unroll
        for (int bj = 0; bj < 2; ++bj)
#pragma unroll
            for (int n = 0; n < 2; ++n) gv[bj][n] = *(const f32x4*)(gate + bi * 6144 + col0 + bj * HALF + 4 * n);
#pragma unroll
        for (int ai = 0; ai < 2; ++ai)
#pragma unroll
            for (int m = 0; m < 4; ++m) { const int r = row0 + ai * HALF + m * 16;
#pragma unroll
                for (int bj = 0; bj < 2; ++bj) { const int c = col0 + bj * HALF; f32x4 h0, h1;
                    if (hin32_lat) { const float* s = (r < NLAT ? hin32_lat + (size_t)r * DM : hin32_ctx + (size_t)(r - NLAT) * DM) + c; h0 = *(const f32x4*)s; h1 = *(const f32x4*)(s + 4); }
                    else { const u32x4 w = *(const u32x4*)(hin + (size_t)r * DM + c);
                        h0 = (f32x4){bf2f(w.x & 0xffffu), bf2f(w.x >> 16), bf2f(w.y & 0xffffu), bf2f(w.y >> 16)}; h1 = (f32x4){bf2f(w.z & 0xffffu), bf2f(w.z >> 16), bf2f(w.w & 0xffffu), bf2f(w.w >> 16)}; }
                    const f32x4 o0 = h0 + gv[bj][0] * acc[ai][bj][m][0], o1 = h1 + gv[bj][1] * acc[ai][bj][m][1];
                    u32x4 w2; w2.x = cvt_pk_bf16(o0[0], o0[1]); w2.y = cvt_pk_bf16(o0[2], o0[3]); w2.z = cvt_pk_bf16(o1[0], o1[1]); w2.w = cvt_pk_bf16(o1[2], o1[3]);
                    *(u32x4*)(out + (size_t)r * DM + c) = w2; } }
    }
};
struct EpiDft {
    static constexpr bool PERM = true;
    bf16_t* MIX; int rowbase; int Lseq;
    __device__ __forceinline__ void operator()(const Acc& acc, const Unit& u, int wr, int wc, int fr, int fq) const {
        const int k0 = u.pm * BM + wr * 64 + fr;
#pragma unroll
        for (int bj = 0; bj < 2; ++bj) { const int c = u.pn * BM + bj * HALF + wc * 32 + 8 * fq, b = c >> 9, cc = c & 511;
#pragma unroll
            for (int ai = 0; ai < 2; ++ai)
#pragma unroll
                for (int m = 0; m < 4; ++m) { const int k = k0 + ai * HALF + m * 16; const f32x4 v0 = acc[ai][bj][m][0], v1 = acc[ai][bj][m][1];
                    u32x4 w; w.x = cvt_pk_bf16(v0[0], v0[1]); w.y = cvt_pk_bf16(v0[2], v0[3]); w.z = cvt_pk_bf16(v1[0], v1[1]); w.w = cvt_pk_bf16(v1[2], v1[3]);
                    *(u32x4*)(MIX + (size_t)(rowbase + b * Lseq + k) * DM + cc) = w; } }
    }
};
struct EpiBf {
    static constexpr bool PERM = true;
    bf16_t* O; int ldc;
    __device__ __forceinline__ void operator()(const Acc& acc, const Unit& u, int wr, int wc, int fr, int fq) const {
        const int row0 = u.pm * BM + wr * 64 + fr, col0 = u.pn * BM + wc * 32 + 8 * fq;
#pragma unroll
        for (int ai = 0; ai < 2; ++ai)
#pragma unroll
            for (int m = 0; m < 4; ++m) { bf16_t* rowp = O + (size_t)(row0 + ai * HALF + m * 16) * ldc + col0;
#pragma unroll
                for (int bj = 0; bj < 2; ++bj) { const f32x4 v0 = acc[ai][bj][m][0], v1 = acc[ai][bj][m][1];
                    u32x4 w; w.x = cvt_pk_bf16(v0[0], v0[1]); w.y = cvt_pk_bf16(v0[2], v0[3]); w.z = cvt_pk_bf16(v1[0], v1[1]); w.w = cvt_pk_bf16(v1[2], v1[3]);
                    *(u32x4*)(rowp + bj * HALF) = w; } }
    }
};
template <int CTRL> __device__ __forceinline__ float dppf(float x) { return __builtin_bit_cast(float, __builtin_amdgcn_mov_dpp(__builtin_bit_cast(int, x), CTRL, 0xf, 0xf, true)); }
struct EpiUp {
    static constexpr bool PERM = true;
    bf16_t* GH; const float* wconv; const float* bconv; int nrows;
    template <bool MASK> __device__ __forceinline__ void run(const Acc& acc, const Unit& u, int wr, int wc, int fr, int fq) const {
        const int jff = u.pn * 128 + wc * 32 + 8 * fq;
        const float z0 = (fr == 0) ? 1.f : 0.f, z15 = (fr == 15) ? 1.f : 0.f;
        unsigned outp[2][4][4];
#pragma unroll
        for (int n = 0; n < 2; ++n) {
            f32x4 w0[2], w1[2], w2[2], bb[2];
#pragma unroll
            for (int bj = 0; bj < 2; ++bj) { const int col = bj * DFF + jff + 4 * n;
                w0[bj] = *(const f32x4*)(wconv + col); w1[bj] = *(const f32x4*)(wconv + NUP + col); w2[bj] = *(const f32x4*)(wconv + 2 * NUP + col); bb[bj] = *(const f32x4*)(bconv + col); }
#pragma unroll
            for (int ai = 0; ai < 2; ++ai) {
                const int rbase = u.pm * 248 + 62 * (2 * ai + wr) - 1;
                float mp[4], mn[4];
                if (MASK) {
#pragma unroll
                    for (int m = 0; m < 4; ++m) { const int r = rbase + 16 * m + fr; const int t = r < NLAT ? (r & 8191) : ((r - NLAT) & 255); const int lastt = r < NLAT ? 8191 : 255;
                        mp[m] = (t == 0) ? 0.f : 1.f; mn[m] = (t == lastt) ? 0.f : 1.f; } }
#pragma unroll
                for (int jp = 0; jp < 2; ++jp) {
                    float res[4][2];
#pragma unroll
                    for (int jj = 0; jj < 2; ++jj) { const int j = jp * 2 + jj;
                        float cv[2][4];
#pragma unroll
                        for (int bj = 0; bj < 2; ++bj) {
                            const float c0 = w0[bj][j], c1 = w1[bj][j], c2 = w2[bj][j], cb = bb[bj][j], c0z = c0 * z0, c2z = c2 * z15;
#pragma unroll
                            for (int m = 0; m < 4; ++m) { const float x = acc[ai][bj][m][n][j];
                                if (MASK) {
                                    float pv = dppf<0x111>(x), nx = dppf<0x101>(x);
                                    if (m > 0) pv += z0 * dppf<0x121>(acc[ai][bj][m > 0 ? m - 1 : 0][n][j]);
                                    if (m < 3) nx += z15 * dppf<0x12F>(acc[ai][bj][m < 3 ? m + 1 : 3][n][j]);
                                    cv[bj][m] = cb + c0 * (pv * mp[m]) + c1 * x + c2 * (nx * mn[m]);
                                } else {
                                    float s = fmaf(c1, x, cb);
                                    const float xm = acc[ai][bj][m > 0 ? m - 1 : 0][n][j], xp = acc[ai][bj][m < 3 ? m + 1 : 3][n][j];
                                    if (m == 0) asm volatile("s_nop 4\n\tv_fmac_f32_dpp %0, %1, %2 row_shr:1 row_mask:0xf bank_mask:0xf\n\tv_fmac_f32_dpp %0, %1, %3 row_shl:1 row_mask:0xf bank_mask:0xf\n\tv_fmac_f32_dpp %0, %4, %5 row_ror:15 row_mask:0xf bank_mask:0xf"
                                                             : "+v"(s) : "v"(x), "v"(c0), "v"(c2), "v"(xp), "v"(c2z));
                                    else if (m == 3) asm volatile("s_nop 4\n\tv_fmac_f32_dpp %0, %1, %2 row_shr:1 row_mask:0xf bank_mask:0xf\n\tv_fmac_f32_dpp %0, %1, %3 row_shl:1 row_mask:0xf bank_mask:0xf\n\tv_fmac_f32_dpp %0, %4, %5 row_ror:1 row_mask:0xf bank_mask:0xf"
                                                             : "+v"(s) : "v"(x), "v"(c0), "v"(c2), "v"(xm), "v"(c0z));
                                    else asm volatile("s_nop 4\n\tv_fmac_f32_dpp %0, %1, %2 row_shr:1 row_mask:0xf bank_mask:0xf\n\tv_fmac_f32_dpp %0, %1, %3 row_shl:1 row_mask:0xf bank_mask:0xf\n\tv_fmac_f32_dpp %0, %4, %5 row_ror:1 row_mask:0xf bank_mask:0xf\n\tv_fmac_f32_dpp %0, %6, %7 row_ror:15 row_mask:0xf bank_mask:0xf"
                                                             : "+v"(s) : "v"(x), "v"(c0), "v"(c2), "v"(xm), "v"(c0z), "v"(xp), "v"(c2z));
                                    cv[bj][m] = s; } }
                        }
#pragma unroll
                        for (int m = 0; m < 4; ++m) res[m][jj] = silu_f(cv[0][m]) * cv[1][m];
                    }
#pragma unroll
                    for (int m = 0; m < 4; ++m) outp[ai][m][n * 2 + jp] = cvt_pk_bf16(res[m][0], res[m][1]);
                }
            }
        }
#pragma unroll
        for (int ai = 0; ai < 2; ++ai) { const int rbase = u.pm * 248 + 62 * (2 * ai + wr) - 1;
#pragma unroll
            for (int m = 0; m < 4; ++m) { const int q = 16 * m + fr, r = rbase + q;
                if (q >= 1 && q <= 62 && r < nrows) { u32x4 w; w.x = outp[ai][m][0]; w.y = outp[ai][m][1]; w.z = outp[ai][m][2]; w.w = outp[ai][m][3]; *(u32x4*)(GH + (size_t)r * DFF + jff) = w; } } }
    }
    __device__ __forceinline__ void operator()(const Acc& acc, const Unit& u, int wr, int wc, int fr, int fq) const {
        const int lo = u.pm * 248 - 1, hi = lo + 248;
        const bool bnd = (hi >= NLAT) || ((lo & ~8191) != (hi & ~8191)) || ((lo & 8191) == 0) || ((hi & 8191) == 8191) || lo < 0 || ((lo & 8191) == 8191) || ((hi & 8191) == 0);
        if (bnd) run<true>(acc, u, wr, wc, fr, fq); else run<false>(acc, u, wr, wc, fr, fq);
    }
};
}

namespace att {
constexpr int D = 128, NW = 8, QBLK = 32, KVBLK = 64;
constexpr float SCALE = 0.088388347648318440f;
constexpr float THR = 8.f;
constexpr int LDQ = 1024, LDK = 256, LDO = 1024;
constexpr size_t SHM_V = KVBLK * D * 2, SHM_K = KVBLK * D * 2, SHM_ATTN = 2 * SHM_V + 2 * SHM_K + NW * 64 * 4;
#define KSWZ(row, colB) ((row) * 256 + ((colB) ^ (((row) & 7) << 4)))
#define SBAR() __builtin_amdgcn_sched_barrier(0)
__device__ __forceinline__ int crow(int r, int hi) { return (r & 3) + 8 * (r >> 2) + 4 * hi; }
__device__ __forceinline__ unsigned cvtpk(float lo, float hi) { unsigned r; asm volatile("v_cvt_pk_bf16_f32 %0, %1, %2" : "=v"(r) : "v"(lo), "v"(hi)); return r; }
__device__ __forceinline__ bf16x8 ld8(const bf16_t* p) { return *reinterpret_cast<const bf16x8*>(p); }
__device__ __forceinline__ void partialSM(f32x16& p0, f32x16& p1, float& m_reg, float& mn, float& alpha) {
  constexpr float C = SCALE * 1.4426950408889634f;
  float pmax = p0[0]; for (int r = 1; r < 16; ++r) pmax = fmaxf(pmax, p0[r]); for (int r = 0; r < 16; ++r) pmax = fmaxf(pmax, p1[r]);
  { auto rr = __builtin_amdgcn_permlane32_swap(__float_as_uint(pmax), __float_as_uint(pmax), false, false);
    pmax = fmaxf(__uint_as_float(rr[0]), __uint_as_float(rr[1])); }
  if (__builtin_expect(__all(pmax - m_reg <= THR / SCALE), 1)) { mn = m_reg; alpha = 1.f; }
  else { mn = fmaxf(m_reg, pmax); alpha = __builtin_amdgcn_exp2f((m_reg - mn) * C); m_reg = mn; }
  float mnC = -mn * C;
  for (int r = 0; r < 16; ++r) p0[r] = fmaf(p0[r], C, mnC); for (int r = 0; r < 16; ++r) p1[r] = fmaf(p1[r], C, mnC);
  for (int r = 0; r < 16; ++r) p0[r] = __builtin_amdgcn_exp2f(p0[r]);
}
__device__ __forceinline__ void finishSM(f32x16& p0, f32x16& p1, float alpha, float& l_reg, bf16x8& pa0, bf16x8& pa1, bf16x8& pa2, bf16x8& pa3) {
  for (int r = 0; r < 16; ++r) p1[r] = __builtin_amdgcn_exp2f(p1[r]);
  float ps = 0; for (int r = 0; r < 16; ++r) ps += p0[r]; for (int r = 0; r < 16; ++r) ps += p1[r];
  { auto rr = __builtin_amdgcn_permlane32_swap(__float_as_uint(ps), __float_as_uint(ps), false, false);
    ps = __uint_as_float(rr[0]) + __uint_as_float(rr[1]); }
  l_reg = l_reg * alpha + ps;
#define PK4(P, BASE, OUT) do { unsigned a0 = cvtpk(P[BASE + 0], P[BASE + 1]), a1 = cvtpk(P[BASE + 2], P[BASE + 3]);   \
    unsigned b0 = cvtpk(P[BASE + 4], P[BASE + 5]), b1 = cvtpk(P[BASE + 6], P[BASE + 7]);                              \
    auto r0 = __builtin_amdgcn_permlane32_swap(a0, b0, false, false); auto r1 = __builtin_amdgcn_permlane32_swap(a1, b1, false, false); \
    u32x4 w = {r0[0], r1[0], r0[1], r1[1]}; OUT = *reinterpret_cast<bf16x8*>(&w); } while (0)
  PK4(p0, 0, pa0); PK4(p0, 8, pa1); PK4(p1, 0, pa2); PK4(p1, 8, pa3);
#undef PK4
}
__device__ __forceinline__ void qkt(f32x16& p0, f32x16& p1, const bf16_t* Ks, const bf16x8* qr, int r32, int hi) {
  p0 = f32x16{}; p1 = f32x16{};
  for (int d0 = 0; d0 < 8; ++d0) { int cb = (d0 * 16 + hi * 8) * 2;
    bf16x8 b0 = *reinterpret_cast<const bf16x8*>((const char*)Ks + KSWZ(r32, cb));
    bf16x8 b1 = *reinterpret_cast<const bf16x8*>((const char*)Ks + KSWZ(32 + r32, cb));
    p0 = __builtin_amdgcn_mfma_f32_32x32x16_bf16(b0, qr[d0], p0, 0, 0, 0);
    p1 = __builtin_amdgcn_mfma_f32_32x32x16_bf16(b1, qr[d0], p1, 0, 0, 0); }
}
__device__ __forceinline__ int v_st(int k, int c) { const int kk = (k & ~0xC) | ((k & 4) << 1) | ((k & 8) >> 1); return ((kk >> 3) * 4 + (c >> 5)) * 512 + ((kk & 7) * 32 + (c & 31)) * 2; }
__device__ __forceinline__ int v_rd_base(int lane) { return ((lane & 3) << 3) | (((lane >> 2) & 3) << 6) | (((lane >> 4) & 1) << 5) | (((lane >> 5) & 1) << 8); }
constexpr int v_rd_off(int d0, int ks, int half) { return d0 * 512 + ks * 4096 + half * 2048; }
template <int OFF> __device__ __forceinline__ s16x4 tr_read(int vb) {
  s16x4 r; asm volatile("ds_read_b64_tr_b16 %0, %1 offset:%2" : "=&v"(r) : "v"(vb), "i"(OFF) : "memory"); return r;
}
template <int D0> __device__ __forceinline__ void pv_one(f32x16& od, int vb, bf16x8 pa0, bf16x8 pa1, bf16x8 pa2, bf16x8 pa3) {
  const s16x4 l0 = tr_read<v_rd_off(D0, 0, 0)>(vb), h0 = tr_read<v_rd_off(D0, 0, 1)>(vb), l1 = tr_read<v_rd_off(D0, 1, 0)>(vb), h1 = tr_read<v_rd_off(D0, 1, 1)>(vb);
  const s16x4 l2 = tr_read<v_rd_off(D0, 2, 0)>(vb), h2 = tr_read<v_rd_off(D0, 2, 1)>(vb), l3 = tr_read<v_rd_off(D0, 3, 0)>(vb), h3 = tr_read<v_rd_off(D0, 3, 1)>(vb);
  asm volatile("s_waitcnt lgkmcnt(0)" ::: "memory"); SBAR();
#define PK(L, H) (bf16x8){L[0], L[1], L[2], L[3], H[0], H[1], H[2], H[3]}
  od = __builtin_amdgcn_mfma_f32_32x32x16_bf16(pa0, PK(l0, h0), od, 0, 0, 0);
  od = __builtin_amdgcn_mfma_f32_32x32x16_bf16(pa1, PK(l1, h1), od, 0, 0, 0);
  od = __builtin_amdgcn_mfma_f32_32x32x16_bf16(pa2, PK(l2, h2), od, 0, 0, 0);
  od = __builtin_amdgcn_mfma_f32_32x32x16_bf16(pa3, PK(l3, h3), od, 0, 0, 0);
#undef PK
}
__device__ __forceinline__ void pv_d0(f32x16* o, int vb, bf16x8 pa0, bf16x8 pa1, bf16x8 pa2, bf16x8 pa3) {
  pv_one<0>(o[0], vb, pa0, pa1, pa2, pa3); pv_one<1>(o[1], vb, pa0, pa1, pa2, pa3); pv_one<2>(o[2], vb, pa0, pa1, pa2, pa3); pv_one<3>(o[3], vb, pa0, pa1, pa2, pa3);
}
__device__ __forceinline__ void attn_dense_body(const bf16_t* __restrict__ Qb, const bf16_t* __restrict__ Kh, const bf16_t* __restrict__ Vh,
                                                bf16_t* __restrict__ Ob, int seq, char* lds, const int tid) {
  constexpr int SDEPTH = 2;
  const int wid = tid >> 6, lane = tid & 63, r32 = lane & 31, hi = lane >> 5;
  bf16_t* V_lds = (bf16_t*)lds; bf16_t* K_lds = (bf16_t*)(lds + 2 * SHM_V);
  float* ws = (float*)(lds + 2 * SHM_V + 2 * SHM_K) + wid * 64; float* li_l = ws; float* al_l = ws + 32;
  float m_reg = -1e30f, l_reg = 0; f32x16 o[4] = {}; bf16x8 qr[8];
  const bf16_t* Qw = Qb + (long)(wid * QBLK + r32) * LDQ + hi * 8;
#pragma unroll
  for (int d0 = 0; d0 < 8; ++d0) qr[d0] = ld8(Qw + d0 * 16);
  const int sr = tid >> 4, sc = (tid & 15) * 8, vst0 = v_st(sr, sc), vst1 = v_st(32 + sr, sc);
  const int vb0 = (int)(uintptr_t)V_lds + v_rd_base(lane);
  struct { bf16x8 vs0, vs1, ks0, ks1; } sr_[SDEPTH];
#define SLOAD(i, k0) do { sr_[i].vs0 = ld8(&Vh[(long)((k0) + sr) * LDK + sc]); sr_[i].vs1 = ld8(&Vh[(long)((k0) + 32 + sr) * LDK + sc]); \
    sr_[i].ks0 = ld8(&Kh[(long)((k0) + sr) * LDK + sc]); sr_[i].ks1 = ld8(&Kh[(long)((k0) + 32 + sr) * LDK + sc]); } while (0)
#define SWRITE(b, i) do { *(bf16x8*)((char*)V_lds + (b) * SHM_V + vst0) = sr_[i].vs0;          \
    *(bf16x8*)((char*)V_lds + (b) * SHM_V + vst1) = sr_[i].vs1; int kc = sc * 2;               \
    *(bf16x8*)((char*)K_lds + (b) * SHM_K + KSWZ(sr, kc)) = sr_[i].ks0;                       \
    *(bf16x8*)((char*)K_lds + (b) * SHM_K + KSWZ(32 + sr, kc)) = sr_[i].ks1; } while (0)
#define SWAIT() asm volatile("s_waitcnt vmcnt(4)" ::: "memory")
#define RESC(a) do { if (__any((a) < 1.f)) { if (hi == 0) al_l[r32] = (a); asm volatile("s_waitcnt lgkmcnt(0)" ::: "memory"); \
    for (int d = 0; d < 4; ++d) for (int r = 0; r < 16; ++r) o[d][r] *= al_l[crow(r, hi)]; } } while (0)
  f32x16 pA0, pA1, pB0, pB1; float mnA, mnB, alA, alB; bf16x8 pa0, pa1, pa2, pa3; const int NT = seq / KVBLK;
  constexpr int SE = 0, SO = SDEPTH - 1;
  SLOAD(SE, 0); asm volatile("s_waitcnt vmcnt(0)" ::: "memory"); SWRITE(0, SE); __syncthreads();
  qkt(pA0, pA1, K_lds, qr, r32, hi); partialSM(pA0, pA1, m_reg, mnA, alA);
  SLOAD(SO, KVBLK); if (2 < NT) SLOAD(SE, 2 * KVBLK);
  SWAIT(); SWRITE(1, SO); __syncthreads();
  for (int j = 1; j + 1 < NT; j += 2) {
    SBAR(); qkt(pB0, pB1, (bf16_t*)((char*)K_lds + SHM_K), qr, r32, hi);
    finishSM(pA0, pA1, alA, l_reg, pa0, pa1, pa2, pa3); SBAR();
    SLOAD(SO, (j + SDEPTH) * KVBLK); SBAR();
    pv_d0(o, vb0, pa0, pa1, pa2, pa3); partialSM(pB0, pB1, m_reg, mnB, alB);
    __syncthreads(); SWAIT(); SWRITE(0, SE);
    RESC(alB); __syncthreads();
    SBAR(); qkt(pA0, pA1, K_lds, qr, r32, hi);
    finishSM(pB0, pB1, alB, l_reg, pa0, pa1, pa2, pa3); SBAR();
    if (j + 3 < NT) SLOAD(SE, (j + 1 + SDEPTH) * KVBLK); SBAR();
    pv_d0(o, vb0 + (int)SHM_V, pa0, pa1, pa2, pa3); partialSM(pA0, pA1, m_reg, mnA, alA);
    __syncthreads(); SWAIT(); SWRITE(1, SO);
    RESC(alA); __syncthreads();
  }
  SBAR(); qkt(pB0, pB1, (bf16_t*)((char*)K_lds + SHM_K), qr, r32, hi);
  finishSM(pA0, pA1, alA, l_reg, pa0, pa1, pa2, pa3); SBAR();
  pv_d0(o, vb0, pa0, pa1, pa2, pa3); partialSM(pB0, pB1, m_reg, mnB, alB);
  __syncthreads(); RESC(alB);
  finishSM(pB0, pB1, alB, l_reg, pa0, pa1, pa2, pa3); SBAR();
  pv_d0(o, vb0 + (int)SHM_V, pa0, pa1, pa2, pa3);
  if (hi == 0) li_l[r32] = l_reg; asm volatile("s_waitcnt lgkmcnt(0)" ::: "memory");
  float rli[16];
#pragma unroll
  for (int r = 0; r < 16; ++r) rli[r] = __builtin_amdgcn_rcpf(li_l[crow(r, hi)]);
  bf16_t* Ow = Ob + (long)(wid * QBLK) * LDO;
#pragma unroll
  for (int r = 0; r < 16; ++r) { int orow = crow(r, hi);
    for (int d0 = 0; d0 < 4; ++d0) Ow[(long)orow * LDO + d0 * 32 + r32] = (bf16_t)f2bf(o[d0][r] * rli[r]); }
#undef SLOAD
#undef SWRITE
#undef SWAIT
#undef RESC
}
}

struct Params {
    const float *x, *c, *ctx, *c_ctx, *w_mod, *b_mod, *g_mix, *g_ffn, *g_final, *w_in, *w_gate, *b_gate, *g_gla, *w_out, *w_qkv, *g_q, *g_k, *w_att, *w_up, *w_conv, *b_conv, *w_dn;
    float* out; unsigned char* ws;
};
struct Ctx { int tid, lane, wave, gw, NGW, G, bid; LAS unsigned char* lds; };

__device__ double cos_poly(double x) { const double x2 = x * x; double r = 1.0; for (int k = 18; k >= 1; --k) r = 1.0 - x2 / (double)((2 * k - 1) * (2 * k)) * r; return r; }
__device__ double sin_poly(double x) { const double x2 = x * x; double r = 1.0; for (int k = 18; k >= 1; --k) r = 1.0 - x2 / (double)((2 * k) * (2 * k + 1)) * r; return x * r; }
constexpr double TWO_PI = 6.283185307179586476925286766559;

__device__ __forceinline__ void tr_item(const float* W, int ldw, int colmax, int K, bf16_t* WT, int kb, int c0, int drow0, LAS float* scr, int lane) {
    const int k0 = 64 * kb, col = c0 + (lane & 31);
    float wv_[32];
#pragma unroll
    for (int i = 0; i < 32; ++i) { const int kk = 2 * i + (lane >> 5); wv_[i] = (col < colmax) ? W[(size_t)(k0 + kk) * ldw + col] : 0.f; }
#pragma unroll
    for (int i = 0; i < 32; ++i) { const int kk = 2 * i + (lane >> 5); scr[kk * 33 + (lane & 31)] = wv_[i]; }
    LDS_WAIT(); asm volatile("" ::: "memory");
    const int c = lane & 7;
#pragma unroll
    for (int j = 0; j < 4; ++j) { const int n = (lane >> 3) + 8 * j; const LAS float* s = scr + (8 * c) * 33 + n;
        u32x4 o; o.x = pk2(s[0 * 33], s[1 * 33]); o.y = pk2(s[2 * 33], s[3 * 33]); o.z = pk2(s[4 * 33], s[5 * 33]); o.w = pk2(s[6 * 33], s[7 * 33]);
        *(u32x4*)(WT + (size_t)(drow0 + n) * K + k0 + 8 * c) = o; }
    LDS_WAIT(); asm volatile("" ::: "memory");
}

__device__ __forceinline__ void phase0(const Params& p, const Ctx& F) {
    LAS float* scr = (LAS float*)(F.lds + F.wave * 16384);
    LAS float* tab = scr + 3072;
    for (int n = F.lane; n < 128; n += 64) { double xx = TWO_PI * (double)n / 128.0; if (n > 64) xx -= TWO_PI; tab[n] = (float)cos_poly(xx); }
    LDS_WAIT();
    bf16_t* WIN = (bf16_t*)(p.ws + O_WIN); bf16_t* WOUT = (bf16_t*)(p.ws + O_WOUT); bf16_t* WQKV = (bf16_t*)(p.ws + O_WQKV); bf16_t* WATT = (bf16_t*)(p.ws + O_WATT);
    bf16_t* WUP = (bf16_t*)(p.ws + O_WUP); bf16_t* WDN = (bf16_t*)(p.ws + O_WDN);
    float* PART = (float*)(p.ws + O_PART); float* COST = (float*)(p.ws + O_COST); float* ROPE = (float*)(p.ws + O_ROPE);
    constexpr int I_IN = 16 * 49, I_OUT = 16 * 32, I_QKV = 16 * 48, I_ATT = 16 * 32, I_UP = 2 * 16 * 176, I_DN = 2 * 44 * 32, I_FOLD = 4 * 128, I_ADA = 2 * 24 * 32, I_COS = 128, I_ROPE = 64, I_PADZ = 55;
    constexpr int NITEMS = I_IN + I_OUT + I_QKV + I_ATT + I_UP + I_DN + I_FOLD + I_ADA + I_COS + I_ROPE + I_PADZ;
    for (int it = F.gw; it < NITEMS; it += F.NGW) {
        int r = it;
        if (r < I_IN) { const int kb = r / 49, nb = r % 49; tr_item(p.w_in, NIN, NIN, DM, WIN, kb, 512 + 32 * nb, 512 + 32 * nb, scr, F.lane); continue; } r -= I_IN;
        if (r < I_OUT) { const int kb = r / 32, nb = r % 32; tr_item(p.w_out, DM, DM, DM, WOUT, kb, 32 * nb, 32 * nb, scr, F.lane); continue; } r -= I_OUT;
        if (r < I_QKV) { const int kb = r / 48, nb = r % 48; tr_item(p.w_qkv, NQKV, NQKV, DM, WQKV, kb, 32 * nb, 32 * nb, scr, F.lane); continue; } r -= I_QKV;
        if (r < I_ATT) { const int kb = r / 32, nb = r % 32; tr_item(p.w_att, DM, DM, DM, WATT, kb, 32 * nb, 32 * nb, scr, F.lane); continue; } r -= I_ATT;
        if (r < I_UP) { const int l = r / (16 * 176), r2 = r % (16 * 176), kb = r2 / 176, nb = r2 % 176, c0 = 32 * nb, part = c0 / DFF, jf = c0 % DFF;
            tr_item(p.w_up + (size_t)l * DM * NUP, NUP, NUP, DM, WUP + (size_t)l * NUP * DM, kb, c0, 256 * (jf >> 7) + 128 * part + (jf & 127), scr, F.lane); continue; } r -= I_UP;
        if (r < I_DN) { const int l = r / (44 * 32), r2 = r % (44 * 32), kb = r2 / 32, nb = r2 % 32;
            tr_item(p.w_dn + (size_t)l * DFF * DM, DM, DM, DFF, WDN + (size_t)l * DM * DFF, kb, 32 * nb, 32 * nb, scr, F.lane); continue; } r -= I_DN;
        if (r < I_FOLD) {
            const int g = r >> 7, k0 = (r & 127) * 8;
#pragma unroll
            for (int kk = 0; kk < 8; ++kk) { scr[F.lane * 8 + kk] = p.w_in[(size_t)(k0 + kk) * NIN + g * 128 + F.lane]; scr[(F.lane + 64) * 8 + kk] = p.w_in[(size_t)(k0 + kk) * NIN + g * 128 + 64 + F.lane]; }
            LDS_WAIT(); asm volatile("" ::: "memory");
            float ac[2][2][8];
#pragma unroll
            for (int a = 0; a < 2; ++a)
#pragma unroll
                for (int b = 0; b < 2; ++b)
#pragma unroll
                    for (int kk = 0; kk < 8; ++kk) ac[a][b][kk] = 0.f;
            for (int c = 0; c < 128; ++c) {
                const f32x4 wa = *(const LAS f32x4*)(scr + c * 8), wb = *(const LAS f32x4*)(scr + c * 8 + 4);
                const float w[8] = {wa[0], wa[1], wa[2], wa[3], wb[0], wb[1], wb[2], wb[3]};
#pragma unroll
                for (int mi = 0; mi < 2; ++mi) { const int m = F.lane + 64 * mi, i0 = (c * m) & 127; const float cs = tab[i0], sn = tab[(i0 - 32) & 127];
#pragma unroll
                    for (int kk = 0; kk < 8; ++kk) { ac[0][mi][kk] += w[kk] * cs; ac[1][mi][kk] -= w[kk] * sn; } }
            }
            const float sc = 0.08838834764831845f;
#pragma unroll
            for (int part = 0; part < 2; ++part)
#pragma unroll
                for (int mi = 0; mi < 2; ++mi) { const float* a = ac[part][mi]; u32x4 o; o.x = pk2(a[0] * sc, a[1] * sc); o.y = pk2(a[2] * sc, a[3] * sc); o.z = pk2(a[4] * sc, a[5] * sc); o.w = pk2(a[6] * sc, a[7] * sc);
                    if (mi == 0) *(u32x4*)(WIN + (size_t)(g * 128 + part * 64 + F.lane) * DM + k0) = o;
                    else if (part == 0 && F.lane == 0) *(u32x4*)(WIN + (size_t)(2080 + g) * DM + k0) = o; }
            LDS_WAIT(); asm volatile("" ::: "memory");
            continue; } r -= I_FOLD;
        if (r < I_ADA) {
            const int l = r / (24 * 32), r2 = r % (24 * 32), cb = r2 / 32, kc = r2 % 32, col = cb * 256 + F.lane * 4;
            f32x4 a[5];
#pragma unroll
            for (int v = 0; v < 5; ++v) a[v] = (f32x4){0.f, 0.f, 0.f, 0.f};
#pragma unroll
            for (int kk = 0; kk < 32; ++kk) { const int k = kc * 32 + kk; const f32x4 w = *(const f32x4*)(p.w_mod + ((size_t)l * DM + k) * 6144 + col);
#pragma unroll
                for (int v = 0; v < 5; ++v) { const float cvv = v < 4 ? p.c[v * DM + k] : p.c_ctx[k]; a[v] += silu_f(cvv) * w; } }
#pragma unroll
            for (int v = 0; v < 5; ++v) *(f32x4*)(PART + ((size_t)(l * 32 + kc) * 5 + v) * 6144 + col) = a[v];
            continue; } r -= I_ADA;
        if (r < I_COS) { const int n = r * 64 + F.lane; double xx = TWO_PI * (double)n / 8192.0; if (n > 4096) xx -= TWO_PI; COST[n] = (float)cos_poly(xx); continue; } r -= I_COS;
        if (r < I_ROPE) { const int e = r * 64 + F.lane, pos = e >> 5, i = e & 31; double inv = 1.0; for (int q = 0; q < i; ++q) inv *= 0.74989420933245582730;
            const float ang = (float)pos * (float)inv; const double a = (double)ang; const double kk = __builtin_rint(a / TWO_PI); const double rr = a - kk * TWO_PI;
            ROPE[2 * e] = (float)cos_poly(rr); ROPE[2 * e + 1] = (float)sin_poly(rr); continue; } r -= I_ROPE;
        {
            u32x4 z = {0u, 0u, 0u, 0u}; u32x4* dst = (u32x4*)(WIN + (size_t)2084 * DM) + (size_t)r * 512;
#pragma unroll
            for (int q = 0; q < 8; ++q) dst[q * 64 + F.lane] = z; }
    }
}

#define CSWZ(i) ((i) + ((i) >> 5))
__device__ __forceinline__ void dft_gen(bf16_t* dst, int L, int lsh, const LAS float* cosT, long gtid, long nth) {
    const int H = L / 2, L8 = L / 8; const float sc = 1.0f / sqrtf((float)L);
    for (long it = gtid; it < (long)L * L8; it += nth) { const int k = (int)(it / L8), j0 = (int)(it % L8) * 8; float v[8];
#pragma unroll
        for (int e = 0; e < 8; ++e) { const int j = j0 + e; float val;
            if (j < H) val = cosT[CSWZ(((k * j) << lsh) & 8191)];
            else { const int t = j - H; val = (t == 0) ? ((k & 1) ? -1.f : 1.f) : cosT[CSWZ((((k * t) << lsh) - 2048) & 8191)]; }
            v[e] = val * sc; }
        u32x4 o; o.x = pk2(v[0], v[1]); o.y = pk2(v[2], v[3]); o.z = pk2(v[4], v[5]); o.w = pk2(v[6], v[7]);
        *(u32x4*)(dst + (size_t)k * L + j0) = o; }
}
__device__ __forceinline__ void dft_gen_quarter(bf16_t* dst, const LAS float* cosT, long gtid, long nth) {
    const float sc = 1.0f / sqrtf(8192.0f);
    for (long it = gtid; it < (long)8192 * 256; it += nth) { const int r = (int)(it >> 8), t0 = (int)(it & 255) * 8, blk = r >> 11, kp = r & 2047, k = 2 * kp + (blk & 1); const bool sn = blk >= 2; float v[8];
#pragma unroll
        for (int e2 = 0; e2 < 8; ++e2) { const int t = t0 + e2; float val;
            if (!sn) val = cosT[CSWZ((k * t) & 8191)];
            else val = (t == 0) ? ((kp & 1) ? -1.f : 1.f) : cosT[CSWZ(((k * t) - 2048) & 8191)];
            v[e2] = val * sc; }
        u32x4 o; o.x = pk2(v[0], v[1]); o.y = pk2(v[2], v[3]); o.z = pk2(v[4], v[5]); o.w = pk2(v[6], v[7]);
        *(u32x4*)(dst + (size_t)r * 2048 + t0) = o; }
}
__device__ __forceinline__ void phase0b(const Params& p, const Ctx& F) {
    const long gtid = (long)F.bid * 512 + F.tid, nth = (long)F.G * 512;
    const float* PART = (const float*)(p.ws + O_PART); float* MODV = (float*)(p.ws + O_MODV); const float* COST = (const float*)(p.ws + O_COST);
    for (long i = gtid; i < 2 * 5 * 6144; i += nth) { const int l = (int)(i / (5 * 6144)), v = (int)(i / 6144) % 5, n = (int)(i % 6144); float s = p.b_mod[l * 6144 + n];
#pragma unroll 16
        for (int kc = 0; kc < 32; ++kc) s += PART[((size_t)(l * 32 + kc) * 5 + v) * 6144 + n];
        MODV[i] = s; }
}
__device__ __forceinline__ void dft_operands(const Params& p, const Ctx& F) {
    const long gtid = (long)F.bid * 512 + F.tid, nth = (long)F.G * 512; const float* COST = (const float*)(p.ws + O_COST);
    LAS float* ct = (LAS float*)F.lds;
    for (int i = F.tid; i < 8192; i += 512) ct[CSWZ(i)] = COST[i];
    __syncthreads();
    dft_gen_quarter((bf16_t*)p.out, ct, gtid, nth);
    dft_gen((bf16_t*)(p.ws + O_DFTC), CTXL, 5, ct, gtid, nth);
    __syncthreads();
}

__device__ __forceinline__ void normmod(const Ctx& F, const float* hlat, const float* hctx, const float* g, const float* modl, int ishift, int iscale, bf16_t* XN, int nrows) {
    for (int row0 = F.gw; row0 < nrows; row0 += 2 * F.NGW) {
        f32x4 v[2][4];
#pragma unroll
        for (int q = 0; q < 2; ++q) { const int row = row0 + q * F.NGW; if (row < nrows) { const float* src = row < NLAT ? hlat + (size_t)row * DM : hctx + (size_t)(row - NLAT) * DM;
#pragma unroll
            for (int j = 0; j < 4; ++j) v[q][j] = ((const f32x4*)src)[F.lane + 64 * j]; } }
#pragma unroll
        for (int q = 0; q < 2; ++q) { const int row = row0 + q * F.NGW; if (row < nrows) { const int bi = row < NLAT ? (row >> 13) : 4; const float* mv = modl + bi * 6144; float ss = 0.f;
#pragma unroll
            for (int j = 0; j < 4; ++j) ss += (v[q][j][0] * v[q][j][0] + v[q][j][1] * v[q][j][1]) + (v[q][j][2] * v[q][j][2] + v[q][j][3] * v[q][j][3]);
            const float rs = 1.0f / sqrtf(wave_sum(ss) * (1.0f / DM) + EPS);
#pragma unroll
            for (int j = 0; j < 4; ++j) { const int col = 4 * (F.lane + 64 * j); const f32x4 gg = *(const f32x4*)(g + col), sc = *(const f32x4*)(mv + iscale * DM + col), sh = *(const f32x4*)(mv + ishift * DM + col);
                const f32x4 y = v[q][j] * rs * gg * (sc + 1.0f) + sh; u32x2 o; o.x = pk2(y[0], y[1]); o.y = pk2(y[2], y[3]); *(u32x2*)(XN + (size_t)row * DM + col) = o; } } }
    }
}
__device__ __forceinline__ void normmod_b(const Ctx& F, const bf16_t* HB, const float* g, const float* modl, int ishift, int iscale, bf16_t* XN, int nrows) {
    for (int row0 = F.gw; row0 < nrows; row0 += 4 * F.NGW) {
        u32x4 w[4][2];
#pragma unroll
        for (int q = 0; q < 4; ++q) { const int row = row0 + q * F.NGW; if (row < nrows) {
#pragma unroll
            for (int j = 0; j < 2; ++j) w[q][j] = *(const u32x4*)(HB + (size_t)row * DM + 512 * j + 8 * F.lane); } }
#pragma unroll
        for (int q = 0; q < 4; ++q) { const int row = row0 + q * F.NGW; if (row < nrows) {
            const int bi = row < NLAT ? (row >> 13) : 4; const float* mv = modl + bi * 6144; float v[2][8]; float ss = 0.f;
#pragma unroll
            for (int j = 0; j < 2; ++j) { unpack8(w[q][j], v[j]);
#pragma unroll
                for (int e2 = 0; e2 < 8; ++e2) ss += v[j][e2] * v[j][e2]; }
            const float rs = 1.0f / sqrtf(wave_sum(ss) * (1.0f / DM) + EPS);
#pragma unroll
            for (int j = 0; j < 2; ++j) { const int col = 512 * j + 8 * F.lane; float y[8];
#pragma unroll
                for (int q2 = 0; q2 < 2; ++q2) { const f32x4 gg = *(const f32x4*)(g + col + 4 * q2), sc = *(const f32x4*)(mv + iscale * DM + col + 4 * q2), sh = *(const f32x4*)(mv + ishift * DM + col + 4 * q2);
#pragma unroll
                    for (int e2 = 0; e2 < 4; ++e2) y[4 * q2 + e2] = v[j][4 * q2 + e2] * rs * gg[e2] * (sc[e2] + 1.0f) + sh[e2]; }
                u32x4 o; o.x = pk2(y[0], y[1]); o.y = pk2(y[2], y[3]); o.z = pk2(y[4], y[5]); o.w = pk2(y[6], y[7]); *(u32x4*)(XN + (size_t)row * DM + col) = o; } } }
    }
}

__device__ __forceinline__ void fold_pass(const bf16_t* VT, bf16_t* VTF, int L, size_t HS, int RS, long gtid, long nth) {
    const int H = L / 2, L8 = L / 8;
    for (long it = gtid; it < (long)2048 * L8; it += nth) { const int n = (int)(it / L8), j0 = (int)(it % L8) * 8; const bf16_t* row = VT + (size_t)n * 2 * L; float v[8];
        const bool sp = j0 >= H; const int t0 = sp ? j0 - H : j0; const bf16_t* src = row + (sp ? L : 0);
        const u32x4 d = *(const u32x4*)(src + t0); const unsigned dw[4] = {d.x, d.y, d.z, d.w};
#pragma unroll
        for (int e = 0; e < 8; ++e) { const int t = t0 + e; const float a = bf2f((dw[e >> 1] >> ((e & 1) * 16)) & 0xffffu);
            if (t == 0) v[e] = sp ? bf2f(row[H]) : a;
            else { const float m = bf2f(src[L - t]); v[e] = sp ? (a - m) : (a + m); } }
        u32x4 o; o.x = pk2(v[0], v[1]); o.y = pk2(v[2], v[3]); o.z = pk2(v[4], v[5]); o.w = pk2(v[6], v[7]);
        *(u32x4*)(VTF + (sp ? HS : (size_t)0) + (size_t)n * RS + t0) = o; }
}

__device__ __forceinline__ void fold4_pass(const bf16_t* VT, bf16_t* VTF, long gtid, long nth) {
    constexpr int L = 8192, H = 4096, M = 2048; constexpr size_t BS = (size_t)NDC * 2048;
    for (long it = gtid; it < (long)1040 * 256; it += nth) { const int n = (int)(it >> 8), t0 = (int)(it & 255) * 8; const int vrow = n < 1024 ? (n >> 6) * 128 + (n & 63) : (n - 1024) * 128 + 64;
        const bf16_t* x = VT + (size_t)vrow * 2 * L; const bf16_t* y = x + L;
        float xa[8], xb[8], xc[8], xd[8], ya[8], yb[8], yc[8], yd[8];
        unpack8(*(const u32x4*)(x + t0), xa); unpack8(*(const u32x4*)(x + H + t0), xd); unpack8(*(const u32x4*)(y + t0), ya); unpack8(*(const u32x4*)(y + H + t0), yd);
        { float m1[8], m2[8], m3[8], m4[8];
          unpack8(*(const u32x4*)(x + L - t0 - 8), m1); unpack8(*(const u32x4*)(x + H - t0 - 8), m2); unpack8(*(const u32x4*)(y + L - t0 - 8), m3); unpack8(*(const u32x4*)(y + H - t0 - 8), m4);
#pragma unroll
          for (int e2 = 1; e2 < 8; ++e2) { xb[e2] = m1[8 - e2]; xc[e2] = m2[8 - e2]; yb[e2] = m3[8 - e2]; yc[e2] = m4[8 - e2]; }
          xb[0] = t0 > 0 ? bf2f(x[L - t0]) : 0.f; xc[0] = bf2f(x[H - t0]); yb[0] = t0 > 0 ? bf2f(y[L - t0]) : 0.f; yc[0] = bf2f(y[H - t0]); }
        float o0[8], o1[8], o2[8], o3[8];
#pragma unroll
        for (int e2 = 0; e2 < 8; ++e2) { const float xs = xa[e2] + xb[e2], xt = xc[e2] + xd[e2], ys = ya[e2] - yb[e2], yt = yc[e2] - yd[e2];
            o0[e2] = xs + xt; o1[e2] = xs - xt; o2[e2] = ys - yt; o3[e2] = ys + yt; }
        if (t0 == 0) { o0[0] = xa[0] + xc[0]; o1[0] = xa[0] - xc[0]; o2[0] = bf2f(x[M]) + bf2f(x[L - M]); o3[0] = bf2f(y[M]) - bf2f(y[L - M]); }
        const size_t off = (size_t)n * 2048 + t0; u32x4 w;
        w.x = pk2(o0[0], o0[1]); w.y = pk2(o0[2], o0[3]); w.z = pk2(o0[4], o0[5]); w.w = pk2(o0[6], o0[7]); *(u32x4*)(VTF + off) = w;
        w.x = pk2(o1[0], o1[1]); w.y = pk2(o1[2], o1[3]); w.z = pk2(o1[4], o1[5]); w.w = pk2(o1[6], o1[7]); *(u32x4*)(VTF + BS + off) = w;
        w.x = pk2(o2[0], o2[1]); w.y = pk2(o2[2], o2[3]); w.z = pk2(o2[4], o2[5]); w.w = pk2(o2[6], o2[7]); *(u32x4*)(VTF + 2 * BS + off) = w;
        w.x = pk2(o3[0], o3[1]); w.y = pk2(o3[2], o3[3]); w.z = pk2(o3[4], o3[5]); w.w = pk2(o3[6], o3[7]); *(u32x4*)(VTF + 3 * BS + off) = w; }
}

struct GlaUnit { int b, h, row0, pf, pb; };
__device__ __forceinline__ GlaUnit gla_unit(int u) { GlaUnit g; const int bh = u & 15, cc = u >> 4; g.b = bh >> 2; g.h = bh & 3;
    if (cc < 4) { g.row0 = NLAT + g.b * CTXL + 64 * cc; g.pf = cc; g.pb = 3 - cc; } else { g.row0 = g.b * SEQ + 64 * (cc - 4); g.pf = cc; g.pb = 135 - cc; } return g; }
__device__ __forceinline__ size_t sl_off(int dir, int b, int h, int p) { return ((size_t)((dir * 4 + b) * 4 + h) * NCH + p) * 8192; }
__device__ __forceinline__ size_t dec_off(int dir, int b, int h, int p) { return ((size_t)((dir * 4 + b) * 4 + h) * NCH + p) * 64; }
#define LBAR() do { asm volatile("s_waitcnt lgkmcnt(0)" ::: "memory"); __builtin_amdgcn_s_barrier(); asm volatile("" ::: "memory"); } while (0)
__device__ __forceinline__ void gla_cum(const Ctx& F, int dir, LAS float* Bc, const LAS float* Zs, const LAS float* Wg, LAS float* Seg) {
    const int d = F.tid & 63, seg = F.tid >> 6; const LAS float* wgd = Wg + dir * 17 * 64 + d; float t[8];
    float wr[16];
#pragma unroll
    for (int r = 0; r < 16; ++r) wr[r] = wgd[r * 64];
    const float bias = wgd[16 * 64];
#pragma unroll
    for (int it = 0; it < 8; ++it) { const int i = 8 * seg + it; float s = bias;
#pragma unroll
        for (int q = 0; q < 4; ++q) { const f32x4 z = *(const LAS f32x4*)(Zs + i * 16 + 4 * q); s += z[0] * wr[4 * q] + z[1] * wr[4 * q + 1] + z[2] * wr[4 * q + 2] + z[3] * wr[4 * q + 3]; }
        t[it] = (fminf(s, 0.f) - __logf(1.0f + __expf(-fabsf(s)))) * (1.0f / 16.0f); }
    if (dir == 0) {
#pragma unroll
        for (int it = 1; it < 8; ++it) t[it] += t[it - 1];
        Seg[seg * 64 + d] = t[7];
    } else {
#pragma unroll
        for (int it = 6; it >= 0; --it) t[it] += t[it + 1];
        Seg[seg * 64 + d] = t[0];
    }
    LBAR();
    float off = 0.f;
#pragma unroll
    for (int s2 = 0; s2 < 8; ++s2) { const float v = Seg[s2 * 64 + d]; const bool use = dir == 0 ? (s2 < seg) : (s2 > seg); off += use ? v : 0.f; }
#pragma unroll
    for (int it = 0; it < 8; ++it) Bc[(8 * seg + it) * 64 + d] = t[it] + off;
    LBAR();
}
__device__ __forceinline__ void gla_cum2(const Ctx& F, LAS float* Bc0, LAS float* Bc1, const LAS float* Zs, const LAS float* Wg, LAS float* Seg) {
    const int d = F.tid & 63, seg = F.tid >> 6; const LAS float* w0p = Wg + d; const LAS float* w1p = Wg + 17 * 64 + d; float t0[8], t1[8], w0[16], w1[16];
#pragma unroll
    for (int r = 0; r < 16; ++r) { w0[r] = w0p[r * 64]; w1[r] = w1p[r * 64]; }
    const float b0 = w0p[16 * 64], b1 = w1p[16 * 64];
#pragma unroll
    for (int it = 0; it < 8; ++it) { const int i = 8 * seg + it; float s0 = b0, s1 = b1;
#pragma unroll
        for (int q = 0; q < 4; ++q) { const f32x4 z = *(const LAS f32x4*)(Zs + i * 16 + 4 * q);
            s0 += z[0] * w0[4 * q] + z[1] * w0[4 * q + 1] + z[2] * w0[4 * q + 2] + z[3] * w0[4 * q + 3];
            s1 += z[0] * w1[4 * q] + z[1] * w1[4 * q + 1] + z[2] * w1[4 * q + 2] + z[3] * w1[4 * q + 3]; }
        t0[it] = (fminf(s0, 0.f) - __logf(1.0f + __expf(-fabsf(s0)))) * (1.0f / 16.0f);
        t1[it] = (fminf(s1, 0.f) - __logf(1.0f + __expf(-fabsf(s1)))) * (1.0f / 16.0f); }
#pragma unroll
    for (int it = 1; it < 8; ++it) t0[it] += t0[it - 1];
#pragma unroll
    for (int it = 6; it >= 0; --it) t1[it] += t1[it + 1];
    Seg[seg * 64 + d] = t0[7]; Seg[512 + seg * 64 + d] = t1[0];
    LBAR();
    float off0 = 0.f, off1 = 0.f;
#pragma unroll
    for (int s2 = 0; s2 < 8; ++s2) { const float v0 = Seg[s2 * 64 + d], v1 = Seg[512 + s2 * 64 + d]; off0 += (s2 < seg) ? v0 : 0.f; off1 += (s2 > seg) ? v1 : 0.f; }
#pragma unroll
    for (int it = 0; it < 8; ++it) { Bc0[(8 * seg + it) * 64 + d] = t0[it] + off0; Bc1[(8 * seg + it) * 64 + d] = t1[it] + off1; }
    LBAR();
}
#define MFMA32F(a, b, c) __builtin_amdgcn_mfma_f32_32x32x2f32((a), (b), (c), 0, 0, 0)
#define MFMA_K64(acc, AEXPR, BEXPR) do { _Pragma("unroll 1") for (int s_ = 0; s_ < 4; ++s_) { float av_[8], bv_[8]; \
    _Pragma("unroll") for (int j_ = 0; j_ < 8; ++j_) { const int k_ = 16 * s_ + 8 * lh + j_; av_[j_] = AEXPR; bv_[j_] = BEXPR; } \
    u32x4 aw_, bw_; aw_.x = pg8::cvt_pk_bf16(av_[0], av_[1]); aw_.y = pg8::cvt_pk_bf16(av_[2], av_[3]); aw_.z = pg8::cvt_pk_bf16(av_[4], av_[5]); aw_.w = pg8::cvt_pk_bf16(av_[6], av_[7]); \
    bw_.x = pg8::cvt_pk_bf16(bv_[0], bv_[1]); bw_.y = pg8::cvt_pk_bf16(bv_[2], bv_[3]); bw_.z = pg8::cvt_pk_bf16(bv_[4], bv_[5]); bw_.w = pg8::cvt_pk_bf16(bv_[6], bv_[7]); \
    acc = __builtin_amdgcn_mfma_f32_32x32x16_bf16(__builtin_bit_cast(bf16x8, aw_), __builtin_bit_cast(bf16x8, bw_), acc, 0, 0, 0); } } while (0)
#define MFMA_K64X2(accA, accB, A0EXPR, A1EXPR, BEXPR) do { _Pragma("unroll 1") for (int s_ = 0; s_ < 4; ++s_) { float a0_[8], a1_[8], bv_[8]; \
    _Pragma("unroll") for (int j_ = 0; j_ < 8; ++j_) { const int k_ = 16 * s_ + 8 * lh + j_; a0_[j_] = A0EXPR; a1_[j_] = A1EXPR; bv_[j_] = BEXPR; } \
    u32x4 aw_, cw_, bw_; aw_.x = pg8::cvt_pk_bf16(a0_[0], a0_[1]); aw_.y = pg8::cvt_pk_bf16(a0_[2], a0_[3]); aw_.z = pg8::cvt_pk_bf16(a0_[4], a0_[5]); aw_.w = pg8::cvt_pk_bf16(a0_[6], a0_[7]); \
    cw_.x = pg8::cvt_pk_bf16(a1_[0], a1_[1]); cw_.y = pg8::cvt_pk_bf16(a1_[2], a1_[3]); cw_.z = pg8::cvt_pk_bf16(a1_[4], a1_[5]); cw_.w = pg8::cvt_pk_bf16(a1_[6], a1_[7]); \
    bw_.x = pg8::cvt_pk_bf16(bv_[0], bv_[1]); bw_.y = pg8::cvt_pk_bf16(bv_[2], bv_[3]); bw_.z = pg8::cvt_pk_bf16(bv_[4], bv_[5]); bw_.w = pg8::cvt_pk_bf16(bv_[6], bv_[7]); \
    accA = __builtin_amdgcn_mfma_f32_32x32x16_bf16(__builtin_bit_cast(bf16x8, aw_), __builtin_bit_cast(bf16x8, bw_), accA, 0, 0, 0); \
    accB = __builtin_amdgcn_mfma_f32_32x32x16_bf16(__builtin_bit_cast(bf16x8, cw_), __builtin_bit_cast(bf16x8, bw_), accB, 0, 0, 0); } } while (0)
#define GLA_LOADV(g_) do { _Pragma("unroll") for (int q_ = 0; q_ < 2; ++q_) { const int e_ = F.tid + 512 * q_, j_ = e_ >> 4, c8_ = (e_ & 15) * 8; nv[q_] = *(const u32x4*)(P + (size_t)((g_).row0 + j_) * PW + 512 + (g_).h * 128 + c8_); } \
    nk = *(const u32x4*)(P + (size_t)((g_).row0 + sj) * PW + 256 + (g_).h * 64 + sd8); if (F.tid < 256) nz = *(const f32x4*)(Z + (size_t)(g_).row0 * 16 + 4 * F.tid); } while (0)
#define GLA_PUTV() do { _Pragma("unroll") for (int q_ = 0; q_ < 2; ++q_) { const int e_ = F.tid + 512 * q_, j_ = e_ >> 4, c8_ = (e_ & 15) * 8; float v_[8]; unpack8(nv[q_], v_); \
    *(LAS f32x4*)(Vs + j_ * 128 + c8_) = (f32x4){v_[0], v_[1], v_[2], v_[3]}; *(LAS f32x4*)(Vs + j_ * 128 + c8_ + 4) = (f32x4){v_[4], v_[5], v_[6], v_[7]}; } \
    if (F.tid < 256) *(LAS f32x4*)(Zs + 4 * F.tid) = nz; } while (0)
#define GLA_LOADWG(h_) do { LBAR(); for (int e_ = F.tid; e_ < 2 * 17 * 64; e_ += 512) { const int dr_ = e_ / (17 * 64), r_ = (e_ / 64) % 17, d_ = e_ & 63; \
    Wg[e_] = r_ < 16 ? p.w_gate[(size_t)dr_ * 16 * 256 + r_ * 256 + (h_) * 64 + d_] : p.b_gate[dr_ * 256 + (h_) * 64 + d_]; } } while (0)
__device__ __forceinline__ void gla_passA(const Params& p, const Ctx& F) {
    const bf16_t* P = (const bf16_t*)(p.ws + O_P); const float* Z = (const float*)(p.ws + O_Z); bf16_t* SL = (bf16_t*)(p.ws + O_SL); float* DEC = (float*)(p.ws + O_DEC);
    LAS float* Bc0 = (LAS float*)F.lds; LAS float* Bc1 = Bc0 + 4096; LAS float* Kh0 = Bc1 + 4096; LAS float* Kh1 = Kh0 + 4096; LAS float* Vs = Kh1 + 4096;
    LAS float* Zs = Vs + 8192; LAS float* Wg = Zs + 1024; LAS float* Seg = Wg + 2 * 17 * 64;
    const int l31 = F.lane & 31, lh = F.lane >> 5, dt = F.wave >> 2, et = F.wave & 3;
    const int sj = F.tid >> 3, sd8 = (F.tid & 7) * 8;
    constexpr int NU = NCH * 16;
    u32x4 nv[2], nk; f32x4 nz = {0.f, 0.f, 0.f, 0.f}; int hcur = -1;
    int u = F.bid; if (u < NU) { const GlaUnit g0 = gla_unit(u); GLA_LOADV(g0); }
    for (; u < NU; u += F.G) { const GlaUnit g = gla_unit(u);
        if (g.h != hcur) { GLA_LOADWG(g.h); hcur = g.h; }
        GLA_PUTV(); float kr[8]; unpack8(nk, kr);
        if (u + F.G < NU) { const GlaUnit gn = gla_unit(u + F.G); GLA_LOADV(gn); }
        LBAR();
        gla_cum2(F, Bc0, Bc1, Zs, Wg, Seg);
#pragma unroll
        for (int q = 0; q < 8; ++q) { Kh0[sj * 64 + sd8 + q] = kr[q] * __expf(Bc0[63 * 64 + sd8 + q] - Bc0[sj * 64 + sd8 + q]);
                                      Kh1[sj * 64 + sd8 + q] = kr[q] * __expf(Bc1[sd8 + q] - Bc1[sj * 64 + sd8 + q]); }
        if (F.tid < 64) DEC[dec_off(0, g.b, g.h, g.pf) + F.tid] = __expf(Bc0[63 * 64 + F.tid]);
        else if (F.tid < 128) DEC[dec_off(1, g.b, g.h, g.pb) + F.tid - 64] = __expf(Bc1[F.tid - 64]);
        LBAR();
        f32x16 acc0 = {}, acc1 = {};
        MFMA_K64X2(acc0, acc1, Kh0[k_ * 64 + 32 * dt + l31], Kh1[k_ * 64 + 32 * dt + l31], Vs[k_ * 128 + 32 * et + l31]);
        bf16_t* dst0 = SL + sl_off(0, g.b, g.h, g.pf); bf16_t* dst1 = SL + sl_off(1, g.b, g.h, g.pb);
#pragma unroll
        for (int r = 0; r < 16; ++r) { const int d = 32 * dt + (r & 3) + 8 * (r >> 2) + 4 * lh; dst0[d * 128 + 32 * et + l31] = (bf16_t)f2bf(acc0[r]); dst1[d * 128 + 32 * et + l31] = (bf16_t)f2bf(acc1[r]); }
        LBAR();
    }
}
__device__ __forceinline__ void gla_passB(const Params& p, const Ctx& F) {
    bf16_t* SL = (bf16_t*)(p.ws + O_SL); const float* DEC = (const float*)(p.ws + O_DEC);
    for (int pi = F.bid * 512 + F.tid; pi < 32 * 4096; pi += F.G * 512) {
        const int chain = pi >> 12, idx = (pi & 4095) * 2, d = idx >> 7;
        unsigned* sl = (unsigned*)(SL + (size_t)chain * NCH * 8192 + idx); const float* dc = DEC + (size_t)chain * NCH * 64 + d; float s0 = 0.f, s1 = 0.f;
        for (int p0 = 0; p0 < NCH; p0 += 12) { unsigned t[12]; float dd[12];
#pragma unroll
            for (int q = 0; q < 12; ++q) { t[q] = sl[(size_t)(p0 + q) * 4096]; dd[q] = dc[(p0 + q) * 64]; }
#pragma unroll
            for (int q = 0; q < 12; ++q) { sl[(size_t)(p0 + q) * 4096] = pk2(s0, s1); s0 = dd[q] * s0 + bf2f(t[q] & 0xffffu); s1 = dd[q] * s1 + bf2f(t[q] >> 16); } }
    }
}
__device__ __forceinline__ void gla_passC(const Params& p, const Ctx& F) {
    const bf16_t* P = (const bf16_t*)(p.ws + O_P); const float* Z = (const float*)(p.ws + O_Z); const bf16_t* SL = (const bf16_t*)(p.ws + O_SL); bf16_t* MIX = (bf16_t*)(p.ws + O_XN);
    LAS float* Bc = (LAS float*)F.lds;
    LAS float* Qt = Bc + 4096;
    LAS float* Kt = Qt + 64 * 65;
    LAS float* At = Kt + 64 * 65;
    LAS float* Vs = At + 64 * 65;
    LAS float* Ss = Vs + 8192;
    LAS float* Zs = Ss + 8192;
    LAS float* Wg = Zs + 1024;
    LAS float* Seg = Wg + 2 * 17 * 64;
    LAS float* Os = Qt;
    const int l31 = F.lane & 31, lh = F.lane >> 5, it2 = F.wave >> 2, et = F.wave & 3, ita = (F.wave >> 1) & 1, jta = F.wave & 1;
    const int sj = F.tid >> 3, sd8 = (F.tid & 7) * 8;
    constexpr int NU = NCH * 16;
    u32x4 nv[2], nk, nq; f32x4 nz = {0.f, 0.f, 0.f, 0.f}; u32x4 ns[2]; unsigned nrw[8]; int hcur = -1;
#define GLC_LOADMAIN(g_) do { GLA_LOADV(g_); nq = *(const u32x4*)(P + (size_t)((g_).row0 + sj) * PW + (g_).h * 64 + sd8); \
    _Pragma("unroll") for (int q_ = 0; q_ < 8; ++q_) nrw[q_] = *(const unsigned*)(P + (size_t)((g_).row0 + F.wave * 8 + q_) * PW + 1024 + (g_).h * 128 + 2 * F.lane); } while (0)
#define GLC_LOADS(g_, dir_) do { const bf16_t* src_ = SL + sl_off((dir_), (g_).b, (g_).h, (dir_) == 0 ? (g_).pf : (g_).pb); \
    _Pragma("unroll") for (int q_ = 0; q_ < 2; ++q_) ns[q_] = *(const u32x4*)(src_ + 8 * (F.tid + 512 * q_)); } while (0)
#define GLC_PUTS() do { _Pragma("unroll") for (int q_ = 0; q_ < 2; ++q_) { float v_[8]; unpack8(ns[q_], v_); LAS float* d_ = Ss + 8 * (F.tid + 512 * q_); \
    *(LAS f32x4*)d_ = (f32x4){v_[0], v_[1], v_[2], v_[3]}; *(LAS f32x4*)(d_ + 4) = (f32x4){v_[4], v_[5], v_[6], v_[7]}; } } while (0)
    int u = F.bid; if (u < NU) { const GlaUnit g0 = gla_unit(u); GLC_LOADMAIN(g0); GLC_LOADS(g0, 0); }
    for (; u < NU; u += F.G) { const GlaUnit g = gla_unit(u);
        if (g.h != hcur) { GLA_LOADWG(g.h); hcur = g.h; }
        GLA_PUTV(); float qr[8], kr[8]; unpack8(nq, qr); unpack8(nk, kr); unsigned rw[8];
#pragma unroll
        for (int q = 0; q < 8; ++q) rw[q] = nrw[q];
        GLC_PUTS();
        LBAR();
        f32x16 oacc = {};
#pragma unroll
        for (int dir = 0; dir < 2; ++dir) {
            if (dir == 0) GLC_LOADS(g, 1);
            else { GLC_PUTS(); if (u + F.G < NU) { const GlaUnit gn = gla_unit(u + F.G); GLC_LOADMAIN(gn); GLC_LOADS(gn, 0); } }
            gla_cum(F, dir, Bc, Zs, Wg, Seg);
#pragma unroll
            for (int q = 0; q < 8; ++q) { const float bb = Bc[sj * 64 + sd8 + q]; Qt[sj * 65 + sd8 + q] = qr[q] * 0.125f * __expf(bb); Kt[sj * 65 + sd8 + q] = kr[q] * __expf(-bb); }
            LBAR();
            if (F.wave < 4) {
                f32x16 a = {};
                MFMA_K64(a, Qt[(32 * ita + l31) * 65 + k_], Kt[(32 * jta + l31) * 65 + k_]);
#pragma unroll
                for (int r = 0; r < 16; ++r) { const int i = 32 * ita + (r & 3) + 8 * (r >> 2) + 4 * lh, j = 32 * jta + l31; const bool keep = dir == 0 ? (j <= i) : (j >= i);
                    const float v = keep ? a[r] : 0.f; if (dir == 0) At[i * 65 + j] = v; else At[i * 65 + j] += v; }
            }
            MFMA_K64(oacc, Qt[(32 * it2 + l31) * 65 + k_], Ss[k_ * 128 + 32 * et + l31]);
            LBAR();
        }
        MFMA_K64(oacc, At[(32 * it2 + l31) * 65 + k_], Vs[k_ * 128 + 32 * et + l31]);
#pragma unroll
        for (int r = 0; r < 16; ++r) { const int i = 32 * it2 + (r & 3) + 8 * (r >> 2) + 4 * lh; Os[i * 129 + 32 * et + l31] = oacc[r]; }
        LBAR();
        { const int c0 = g.h * 128 + 2 * F.lane; const f32x2 gg = *(const f32x2*)(p.g_gla + c0);
#pragma unroll
          for (int q = 0; q < 8; ++q) { const int i = F.wave * 8 + q, row = g.row0 + i; const float x0 = Os[i * 129 + 2 * F.lane], x1 = Os[i * 129 + 2 * F.lane + 1];
            const float rs = 1.0f / sqrtf(wave_sum(x0 * x0 + x1 * x1) * (1.0f / 128.0f) + EPS);
            const float r0 = bf2f(rw[q] & 0xffffu), r1 = bf2f(rw[q] >> 16);
            *(unsigned*)(MIX + (size_t)row * DM + 512 + c0) = pk2(x0 * rs * gg[0] * silu_f(r0), x1 * rs * gg[1] * silu_f(r1)); } }
        LBAR();
    }
#undef GLC_LOADMAIN
#undef GLC_LOADS
#undef GLC_PUTS
}

__device__ __forceinline__ void dft_combine(const Params& p, const Ctx& F) {
    const bf16_t* PQ = (const bf16_t*)p.out + (size_t)8192 * 2048; const bf16_t* V0 = (const bf16_t*)(p.ws + O_VTF); const bf16_t* V2 = V0 + (size_t)2 * NDC * 2048; bf16_t* MIX = (bf16_t*)(p.ws + O_XN);
    const float sc = 1.0f / sqrtf(8192.0f);
    LAS float* nyq = (LAS float*)F.lds;
    for (int n = F.tid; n < 1040; n += 512) nyq[n] = bf2f(V2[(size_t)n * 2048]);
    __syncthreads();
    for (long it = (long)F.bid * 512 + F.tid; it < (long)4096 * 128; it += (long)F.G * 512) { const int k = (int)(it >> 7), n0 = (int)(it & 127) * 8, bg = n0 >> 6, m0 = n0 & 63, b = bg >> 2, cc = (bg & 3) * 128, par = k & 1, kp = k >> 1;
        float pv[8], qv[8]; unpack8(*(const u32x4*)(PQ + (size_t)(par * 2048 + kp) * NDC + n0), pv); unpack8(*(const u32x4*)(PQ + (size_t)(4096 + par * 2048 + kp) * NDC + n0), qv);
        float f0[8], f1[8]; const float sg = par ? 0.f : ((kp & 1) ? -2.f * sc : 2.f * sc);
#pragma unroll
        for (int e = 0; e < 8; ++e) { f0[e] = pv[e] + qv[e]; f1[e] = pv[e] - qv[e] + sg * nyq[n0 + e]; }
        bf16_t* rk = MIX + (size_t)(b * SEQ + k) * DM + cc; bf16_t* rl = MIX + (size_t)(b * SEQ + (k ? SEQ - k : 0)) * DM + cc;
        u32x4 o; o.x = pk2(f0[0], f0[1]); o.y = pk2(f0[2], f0[3]); o.z = pk2(f0[4], f0[5]); o.w = pk2(f0[6], f0[7]); *(u32x4*)(rk + m0) = o;
        if (k > 0) { u32x4 o1; o1.x = pk2(f1[0], f1[1]); o1.y = pk2(f1[2], f1[3]); o1.z = pk2(f1[4], f1[5]); o1.w = pk2(f1[6], f1[7]); *(u32x4*)(rl + m0) = o1; }
#pragma unroll
        for (int e = 0; e < 8; ++e) { const int m = m0 + e; if (m > 0) { rk[128 - m] = (bf16_t)f2bf(f1[e]); if (k > 0) rl[128 - m] = (bf16_t)f2bf(f0[e]); } } }
    for (long it = (long)F.bid * 512 + F.tid; it < (long)4096 * 16; it += (long)F.G * 512) { const int k = (int)(it >> 4), bg = (int)(it & 15), b = bg >> 2, cc = (bg & 3) * 128 + 64, par = k & 1, kp = k >> 1;
        const float pvv = bf2f(PQ[(size_t)(par * 2048 + kp) * NDC + 1024 + bg]); const float ev = par ? 0.f : ((kp & 1) ? -sc : sc) * nyq[1024 + bg];
        const bf16_t o = (bf16_t)f2bf(pvv + ev); MIX[(size_t)(b * SEQ + k) * DM + cc] = o; if (k > 0) MIX[(size_t)(b * SEQ + SEQ - k) * DM + cc] = o; }
    for (int n = F.gw; n < 1040; n += F.NGW) { const bf16_t* row = V0 + (size_t)n * 2048; float s = 0.f;
#pragma unroll
        for (int q = 0; q < 4; ++q) { float v[8]; unpack8(*(const u32x4*)(row + (q * 64 + F.lane) * 8), v); s += (v[0] - v[1]) + (v[2] - v[3]) + (v[4] - v[5]) + (v[6] - v[7]); }
        s = wave_sum(s);
        if (F.lane == 0) { const int bg = n < 1024 ? (n >> 6) : (n - 1024), m = n < 1024 ? (n & 63) : 64, b = bg >> 2, cc = (bg & 3) * 128; const bf16_t o = (bf16_t)f2bf((s + bf2f(V2[(size_t)n * 2048])) * sc);
            bf16_t* r = MIX + (size_t)(b * SEQ + 4096) * DM + cc; r[m] = o; if (m > 0 && m < 64) r[128 - m] = o; } }
}

__device__ __forceinline__ void rope_pass(const Params& p, const Ctx& F) {
    const bf16_t* QKV = (const bf16_t*)(p.ws + O_QKV); bf16_t* QF = (bf16_t*)(p.ws + O_QF); bf16_t* KALL = (bf16_t*)(p.ws + O_KALL); bf16_t* VALL = (bf16_t*)(p.ws + O_VALL);
    const float* ROPE = (const float*)(p.ws + O_ROPE);
    const int pl = F.lane & 31, half = F.lane >> 5, e0 = half * 64 + 2 * pl;
    for (int row = F.gw; row < MROWS; row += F.NGW) {
        const bool lat = row < NLAT; int b, s, t = 0;
        if (lat) { b = row >> 13; t = row & 8191; s = CTXL + t; } else { b = (row - NLAT) >> 8; s = (row - NLAT) & 255; }
        const int pos = pl < 16 ? (t >> 6) : (t & 63); const f32x4 cs = *(const f32x4*)(ROPE + ((size_t)pos * 32 + 2 * (pl & 15)) * 2);
        const size_t kvo = ((size_t)(b * SKV + s) * 2) * 128;
        unsigned wv[12];
#pragma unroll
        for (int hd = 0; hd < 12; ++hd) wv[hd] = (lat || hd >= 8) ? *(const unsigned*)(QKV + (size_t)row * NQKV + hd * 128 + e0) : 0u;
#pragma unroll
        for (int hd = 0; hd < 12; ++hd) {
            if (!lat && hd < 8) continue;
            const unsigned w = wv[hd];
            if (hd >= 10) { *(unsigned*)(VALL + kvo + (hd - 10) * 128 + e0) = w; continue; }
            float x0 = bf2f(w & 0xffffu), x1 = bf2f(w >> 16);
            const float rs = 1.0f / sqrtf(wave_sum(x0 * x0 + x1 * x1) * (1.0f / 128.0f) + EPS);
            const float* gg = hd < 8 ? p.g_q : p.g_k; x0 *= rs * gg[e0]; x1 *= rs * gg[e0 + 1];
            if (lat) { const float y0 = __shfl_xor(x0, 32), y1 = __shfl_xor(x1, 32); const float sg = half ? 1.f : -1.f;
                x0 = x0 * cs[0] + sg * y0 * cs[1]; x1 = x1 * cs[2] + sg * y1 * cs[3]; }
            const unsigned o = pk2(x0, x1);
            if (hd < 8) *(unsigned*)(QF + (size_t)row * DM + hd * 128 + e0) = o; else *(unsigned*)(KALL + kvo + (hd - 8) * 128 + e0) = o;
        }
    }
}


#define XB_TMO      128
#define XB_XCNT(j)  (256  + 64 * (j))
#define XB_XSUB(j)  (1280 + 64 * (j))
#define XB_XGEN(j)  (2304 + 64 * (j))
#define XB_TOP      3328
#define XB_TOPGEN   3392
#define XCD_BAR_WORDS 3456
#define XB_SPIN_CAP (1u << 20)
__device__ __forceinline__ unsigned xb_ld(unsigned* p)              { return __hip_atomic_load(p, __ATOMIC_RELAXED, __HIP_MEMORY_SCOPE_AGENT); }
__device__ __forceinline__ unsigned xb_add(unsigned* p, unsigned v) { return __hip_atomic_fetch_add(p, v, __ATOMIC_RELAXED, __HIP_MEMORY_SCOPE_AGENT); }
__device__ __forceinline__ unsigned xb_xcc_id() { return (unsigned)__builtin_amdgcn_s_getreg((3 << 11) | 20) & 0xFu; }
#define XB_SPIN(cond, bar) do { unsigned _sp = 0; while (cond) { __builtin_amdgcn_s_sleep(1); \
    if ((++_sp & 255u) == 0u) { if (xb_ld(&(bar)[XB_TMO])) break; if (_sp > XB_SPIN_CAP) { atomicAdd(&(bar)[XB_TMO], 1u); break; } } } } while (0)
struct XcdBarrier { unsigned* bar; unsigned x; volatile LAS unsigned* st; };
__device__ __forceinline__ void xcd_barrier_complete(unsigned* bar, unsigned x, unsigned& nloc, unsigned& nx) {
    const unsigned G = gridDim.x * gridDim.y * gridDim.z;
    unsigned sum, cnt, mine, sp = 0u;
    for (;;) {
        sum = 0u; cnt = 0u; mine = 0u;
#pragma unroll
        for (unsigned j = 0; j < 16; ++j) { const unsigned c = xb_ld(&bar[XB_XCNT(j)]); sum += c; cnt += (c > 0u) ? 1u : 0u; mine = (j == x) ? c : mine; }
        if (sum == G) break;
        __builtin_amdgcn_s_sleep(1);
        if ((++sp & 255u) == 0u) { if (xb_ld(&bar[XB_TMO])) break; if (sp > XB_SPIN_CAP) { atomicAdd(&bar[XB_TMO], 1u); break; } }
    }
    nloc = mine > 0u ? mine : 1u; nx = cnt > 0u ? cnt : 1u;
}
__device__ __forceinline__ void xcd_barrier(const XcdBarrier& b) {
    asm volatile("s_waitcnt vmcnt(0)" ::: "memory");
    __syncthreads();
    if (threadIdx.x == 0) {
        unsigned* bar = b.bar;
        __builtin_amdgcn_s_waitcnt(0);
        unsigned nloc = b.st[0], nx = b.st[1];
        if (nloc == 0u) { xcd_barrier_complete(bar, b.x, nloc, nx); b.st[0] = nloc; b.st[1] = nx; }
        const unsigned old = xb_add(&bar[XB_XSUB(b.x)], 1u);
        const unsigned gen = old / nloc;
        if (old + 1u == (gen + 1u) * nloc) {
            __builtin_amdgcn_fence(__ATOMIC_RELEASE, "agent");
            asm volatile("s_waitcnt vmcnt(0)" ::: "memory");
            const unsigned og = xb_add(&bar[XB_TOP], 1u);
            const unsigned tg = og / nx;
            if (og + 1u == (tg + 1u) * nx) xb_add(&bar[XB_TOPGEN], 1u);
            else XB_SPIN(xb_ld(&bar[XB_TOPGEN]) == tg, bar);
            __builtin_amdgcn_fence(__ATOMIC_ACQUIRE, "agent");
            xb_add(&bar[XB_XGEN(b.x)], 1u);
            asm volatile("s_waitcnt vmcnt(0)" ::: "memory");
        } else {
            XB_SPIN(xb_ld(&bar[XB_XGEN(b.x)]) == gen, bar);
            __builtin_amdgcn_fence(__ATOMIC_ACQUIRE, "agent");
            asm volatile("s_waitcnt vmcnt(0)" ::: "memory");
        }
    }
    __syncthreads();
}
constexpr size_t O_BAR = 512 * 1024;
constexpr int BARST_OFF = LDS_BYTES - 64;
#ifndef DUPMASK
#define DUPMASK 0u
#endif
#define REP(n) for (int rep_ = 0; rep_ < (((DUPMASK) >> (n)) & 1u ? 2 : 1); ++rep_)
#ifdef ONLY
#define PHSEL(n) ((n) == ONLY)
#else
#define PHSEL(n) true
#endif
typedef const __attribute__((address_space(4))) Params* KParams;
#if defined(__HIP_DEVICE_COMPILE__)
#define PH_LOADP KParams kp_ = (KParams)__builtin_amdgcn_kernarg_segment_ptr(); asm volatile("" : "+s"(kp_)); const Params p = *kp_;
#else
#define PH_LOADP const Params p = p_arg;
#endif
#define PH_BEGIN PH_LOADP \
    Ctx F; { int t_ = threadIdx.x; asm volatile("" : "+v"(t_)); int b_ = blockIdx.x, g_ = gridDim.x; asm volatile("" : "+s"(b_), "+s"(g_)); \
      F.tid = t_; F.lane = t_ & 63; F.wave = __builtin_amdgcn_readfirstlane(t_ >> 6); F.G = g_; F.bid = b_; F.gw = b_ * 8 + F.wave; F.NGW = g_ * 8; F.lds = (LAS unsigned char*)lds_raw; } \
    unsigned char* ws = p.ws; float* MODV = (float*)(ws + O_MODV); bf16_t* HB = (bf16_t*)(ws + O_HB); bf16_t* XN = (bf16_t*)(ws + O_XN); const float* MOD1 = MODV + 5 * 6144; \
    const long gtid = (long)F.bid * 512 + F.tid, nth = (long)F.G * 512; (void)MODV; (void)HB; (void)XN; (void)MOD1; (void)gtid; (void)nth;
#define GBAR() do { PH_LOADP XcdBarrier b_; b_.bar = (unsigned*)(p.ws + O_BAR); b_.x = xb_xcc_id(); b_.st = (volatile LAS unsigned*)((LAS unsigned char*)lds_raw + BARST_OFF); xcd_barrier(b_); } while (0)
__global__ void __launch_bounds__(512) fwd_mega(Params p_arg) {
    extern __shared__ __attribute__((aligned(16))) unsigned char lds_raw[];
    cg::grid_group grid = cg::this_grid();
    { PH_LOADP
      if (threadIdx.x < 2) ((LAS unsigned*)((LAS unsigned char*)lds_raw + BARST_OFF))[threadIdx.x] = 0u;
      if (threadIdx.x == 0) (void)xb_add(&((unsigned*)(p.ws + O_BAR))[XB_XCNT(xb_xcc_id())], 1u);
      __syncthreads(); }

    if constexpr (PHSEL(0)) { PH_BEGIN REP(0) {
    phase0(p, F);
    } }
    GBAR();
    if (p_arg.ws == nullptr) grid.sync();
    if constexpr (PHSEL(1)) { PH_BEGIN REP(1) {
    phase0b(p, F);
    } }
    GBAR();
    if constexpr (PHSEL(2)) { PH_BEGIN REP(2) {
    dft_operands(p, F);
    normmod(F, p.x, p.ctx, p.g_mix, MODV, 0, 1, XN, MROWS);
    } }
    GBAR();
    if constexpr (PHSEL(3)) { PH_BEGIN REP(3) {
    { pg8::Gemm g{XN, (const bf16_t*)(ws + O_WIN), DM}; pg8::StaticOrder S; S.init(MROWS / 256, NINP / 256, F.G, F.bid);
      pg8::EpiIn E{(bf16_t*)(ws + O_VT), (bf16_t*)(ws + O_VTC), (bf16_t*)(ws + O_P), (float*)(ws + O_Z)};
      pg8::gemm_phase<pg8::EpiIn, false>(F.lds, g, S, E, F.tid); }
    } }
    GBAR();
    if constexpr (PHSEL(4)) { PH_BEGIN REP(4) {
    gla_passA(p, F);
    fold4_pass((const bf16_t*)(ws + O_VT), (bf16_t*)(ws + O_VTF), gtid, nth);
    fold_pass((const bf16_t*)(ws + O_VTC), (bf16_t*)(ws + O_VTCF), CTXL, (size_t)128, 256, gtid, nth);
    } }
    GBAR();
    if constexpr (PHSEL(5)) { PH_BEGIN REP(5) {
    gla_passB(p, F);
    { pg8::Gemm g{(const bf16_t*)p.out, (const bf16_t*)(ws + O_VTF), 2048, 3, (size_t)NDC * 2048 * 2}; pg8::StaticOrder S; S.init(32, NDC / 256, F.G, F.bid);
      pg8::EpiBf E{(bf16_t*)p.out + (size_t)8192 * 2048, NDC}; pg8::gemm_phase<pg8::EpiBf, false>(F.lds, g, S, E, F.tid); }
    { pg8::Gemm g{(const bf16_t*)(ws + O_DFTC), (const bf16_t*)(ws + O_VTCF), CTXL}; pg8::StaticOrder S; S.init(1, 2048 / 256, F.G, F.bid);
      pg8::EpiDft E{XN, NLAT, CTXL}; pg8::gemm_phase<pg8::EpiDft, false>(F.lds, g, S, E, F.tid); }
    } }
    GBAR();
    if constexpr (PHSEL(6)) { PH_BEGIN REP(6) {
    gla_passC(p, F);
    dft_combine(p, F);
    } }
    GBAR();
    if constexpr (PHSEL(7)) { PH_BEGIN REP(7) {
    { pg8::Gemm g{XN, (const bf16_t*)(ws + O_WOUT), DM}; pg8::StaticOrder S; S.init(MROWS / 256, 4, F.G, F.bid);
      pg8::EpiResB E{p.x, p.ctx, nullptr, HB, MODV + 2 * DM}; pg8::gemm_phase<pg8::EpiResB, false>(F.lds, g, S, E, F.tid); }
    } }
    GBAR();
    if constexpr (PHSEL(8)) { PH_BEGIN REP(8) {
    normmod_b(F, HB, p.g_ffn, MODV, 3, 4, XN, MROWS);
    } }
    GBAR();
    if constexpr (PHSEL(9)) { PH_BEGIN REP(9) {
    { pg8::Gemm g{XN, (const bf16_t*)(ws + O_WUP), DM}; pg8::StaticOrder S; S.init((MROWS + 247) / 248, NUP / 256, F.G, F.bid);
      pg8::EpiUp E{(bf16_t*)(ws + O_GH), p.w_conv, p.b_conv, MROWS}; pg8::gemm_phase<pg8::EpiUp, true>(F.lds, g, S, E, F.tid); }
    } }
    GBAR();
    if constexpr (PHSEL(10)) { PH_BEGIN REP(10) {
    { pg8::Gemm g{(const bf16_t*)(ws + O_GH), (const bf16_t*)(ws + O_WDN), DFF}; pg8::StaticOrder S; S.init(MROWS / 256, 4, F.G, F.bid);
      pg8::EpiResB E{nullptr, nullptr, HB, HB, MODV + 5 * DM}; pg8::gemm_phase<pg8::EpiResB, false>(F.lds, g, S, E, F.tid); }
    } }
    GBAR();
    if constexpr (PHSEL(11)) { PH_BEGIN REP(11) {
    normmod_b(F, HB, p.g_mix + DM, MOD1, 0, 1, XN, MROWS);
    } }
    GBAR();
    if constexpr (PHSEL(12)) { PH_BEGIN REP(12) {
    { pg8::Gemm g{XN, (const bf16_t*)(ws + O_WQKV), DM}; pg8::StaticOrder S; S.init(NLAT / 256, NQKV / 256, F.G, F.bid); S.xn = 8; S.xpm0 = NLAT / 256; S.xpn0 = 4; S.xcols = 2;
      pg8::EpiBf E{(bf16_t*)(ws + O_QKV), NQKV}; pg8::gemm_phase<pg8::EpiBf, false>(F.lds, g, S, E, F.tid); }
    } }
    GBAR();
    if constexpr (PHSEL(13)) { PH_BEGIN REP(13) {
    rope_pass(p, F);
    } }
    GBAR();
    if constexpr (PHSEL(14)) { PH_BEGIN REP(14) {
    { const bf16_t* QF = (const bf16_t*)(ws + O_QF); const bf16_t* KALL = (const bf16_t*)(ws + O_KALL); const bf16_t* VALL = (const bf16_t*)(ws + O_VALL); bf16_t* ATTO = (bf16_t*)(ws + O_ATTO);
      for (int u = F.bid; u < 1024; u += F.G) { const int b = u >> 8, r = u & 255, h = r & 7, qb = r >> 3;
          const size_t qo = (size_t)(b * SEQ + qb * 256) * DM + h * 128, ko = (size_t)b * SKV * 256 + (h >> 2) * 128;
          att::attn_dense_body(QF + qo, KALL + ko, VALL + ko, ATTO + qo, SKV, (char*)lds_raw, F.tid);
          __syncthreads(); } }
    } }
    GBAR();
    if constexpr (PHSEL(15)) { PH_BEGIN REP(15) {
    { pg8::Gemm g{(const bf16_t*)(ws + O_ATTO), (const bf16_t*)(ws + O_WATT), DM}; pg8::StaticOrder S; S.init(NLAT / 256, 4, F.G, F.bid);
      pg8::EpiResB E{nullptr, nullptr, HB, HB, MOD1 + 2 * DM}; pg8::gemm_phase<pg8::EpiResB, false>(F.lds, g, S, E, F.tid); }
    } }
    GBAR();
    if constexpr (PHSEL(16)) { PH_BEGIN REP(16) {
    normmod_b(F, HB, p.g_ffn + DM, MOD1, 3, 4, XN, NLAT);
    } }
    GBAR();
    if constexpr (PHSEL(17)) { PH_BEGIN REP(17) {
    { pg8::Gemm g{XN, (const bf16_t*)(ws + O_WUP) + (size_t)NUP * DM, DM}; pg8::StaticOrder S; S.init((NLAT + 247) / 248, NUP / 256, F.G, F.bid);
      pg8::EpiUp E{(bf16_t*)(ws + O_GH), p.w_conv + 3 * NUP, p.b_conv + NUP, NLAT}; pg8::gemm_phase<pg8::EpiUp, true>(F.lds, g, S, E, F.tid); }
    } }
    GBAR();
    if constexpr (PHSEL(18)) { PH_BEGIN REP(18) {
    { pg8::Gemm g{(const bf16_t*)(ws + O_GH), (const bf16_t*)(ws + O_WDN) + (size_t)DM * DFF, DFF}; pg8::StaticOrder S; S.init(NLAT / 256, 4, F.G, F.bid);
      pg8::EpiResB E{nullptr, nullptr, HB, HB, MOD1 + 5 * DM}; pg8::gemm_phase<pg8::EpiResB, false>(F.lds, g, S, E, F.tid); }
    } }
    GBAR();
    if constexpr (PHSEL(19)) { PH_BEGIN REP(19) {
    for (int row0 = F.gw; row0 < NLAT; row0 += 4 * F.NGW) {
        u32x4 w[4][2];
#pragma unroll
        for (int q = 0; q < 4; ++q) { const int row = row0 + q * F.NGW; if (row < NLAT) {
#pragma unroll
            for (int j = 0; j < 2; ++j) w[q][j] = *(const u32x4*)(HB + (size_t)row * DM + 512 * j + 8 * F.lane); } }
#pragma unroll
        for (int q = 0; q < 4; ++q) { const int row = row0 + q * F.NGW; if (row < NLAT) { float v[2][8]; float ss = 0.f;
#pragma unroll
            for (int j = 0; j < 2; ++j) { unpack8(w[q][j], v[j]);
#pragma unroll
                for (int e2 = 0; e2 < 8; ++e2) ss += v[j][e2] * v[j][e2]; }
            const float rs = 1.0f / sqrtf(wave_sum(ss) * (1.0f / DM) + EPS);
#pragma unroll
            for (int j = 0; j < 2; ++j) { const int col = 512 * j + 8 * F.lane;
#pragma unroll
                for (int q2 = 0; q2 < 2; ++q2) { const f32x4 gg = *(const f32x4*)(p.g_final + col + 4 * q2); f32x4 y;
#pragma unroll
                    for (int e2 = 0; e2 < 4; ++e2) y[e2] = v[j][4 * q2 + e2] * rs * gg[e2];
                    *(f32x4*)(p.out + (size_t)row * DM + col + 4 * q2) = y; } } } } }
    } }
}

extern "C" void kernel_launch(void* const* d_in, const int* in_sizes, int n_in, void* d_out, int out_size, void* d_ws, size_t ws_size, hipStream_t stream) {
    static int grid = 0;
    if (grid == 0) {
        if (n_in != 22 || out_size != NLAT * DM || ws_size < WS_NEED) { fprintf(stderr, "kernel_launch: unexpected shapes n_in %d out %d ws %zu\n", n_in, out_size, ws_size); grid = -1; return; }
        int dev = 0, cus = 0, per_cu = 0;
        hipGetDevice(&dev); hipDeviceGetAttribute(&cus, hipDeviceAttributeMultiprocessorCount, dev);
        if (hipFuncSetAttribute((const void*)fwd_mega, hipFuncAttributeMaxDynamicSharedMemorySize, LDS_BYTES) != hipSuccess) { fprintf(stderr, "kernel_launch: hipFuncSetAttribute failed\n"); grid = -1; return; }
        if (hipOccupancyMaxActiveBlocksPerMultiprocessor(&per_cu, (const void*)fwd_mega, 512, LDS_BYTES) != hipSuccess || per_cu < 1) { fprintf(stderr, "kernel_launch: occupancy query gave %d\n", per_cu); per_cu = 1; }
        (void)hipGetLastError();
        grid = cus * (per_cu > 1 ? 1 : per_cu);
    }
    if (grid < 0) return;
    Params p{};
    const float** pp = (const float**)&p;
    for (int i = 0; i < 22; ++i) pp[i] = (const float*)d_in[i];
    p.out = (float*)d_out; p.ws = (unsigned char*)d_ws;
    if (hipMemsetAsync((char*)d_ws + O_BAR, 0, 16384, stream) != hipSuccess) { fprintf(stderr, "kernel_launch: memset failed\n"); return; }
    void* args[] = {&p};
    hipError_t e = hipLaunchCooperativeKernel((const void*)fwd_mega, dim3(grid), dim3(512), args, LDS_BYTES, stream);
    if (e != hipSuccess) fprintf(stderr, "cooperative launch failed: %s (grid %d)\n", hipGetErrorString(e), grid);
}
```
